# Optimizing an MI355X kernel written in HIP

```python
import math
import jax, jax.numpy as jnp
from jax import lax
import numpy as np

D_MODEL = 1024
BATCH = 4
SEQ = 4096
DEPTH = 4

HEAD_DIM = 64
CHUNK = 128
RET_HEADS = 6
RET_WIDTH = RET_HEADS * HEAD_DIM
MLP_GROUPS = 4
MLP_WIDTH = MLP_GROUPS * HEAD_DIM
ATT_HEADS = 6
ATT_KV_HEADS = 2
ATT_WIDTH = ATT_HEADS * HEAD_DIM
ATT_KV_WIDTH = ATT_KV_HEADS * HEAD_DIM
WINDOW = 128
MIX_WIDTH = RET_WIDTH + MLP_WIDTH + ATT_WIDTH
IN_WIDTH = 4 * RET_WIDTH + 2 * MLP_WIDTH + ATT_WIDTH + 2 * ATT_KV_WIDTH
D_FF = -(-8 * D_MODEL // (3 * 256)) * 256
RET_DECAY_BASE = 5.0
NORM_EPS = 1e-6

kernel_name = "hybrid_retention_gmlp_swa_trunk"


def rms_norm(x, g):
    xf = x.astype(jnp.float32)
    y = xf * lax.rsqrt(jnp.mean(xf * xf, axis=-1, keepdims=True) + NORM_EPS)
    return (y * g.astype(jnp.float32)).astype(x.dtype)


def alibi_slopes(n):
    def pow2(m):
        start = 2.0 ** (-(2.0 ** -(math.log2(m) - 3)))
        return [start * start ** i for i in range(m)]
    if math.log2(n).is_integer():
        s = pow2(n)
    else:
        c = 2 ** int(math.floor(math.log2(n)))
        s = pow2(c) + pow2(2 * c)[0::2][: n - c]
    return jnp.asarray(np.array(s, dtype=np.float32))


def retention(q, k, v):
    B, T, H, d = q.shape
    N = T // CHUNK
    q = q.reshape(B, N, CHUNK, H, d)
    k = k.reshape(B, N, CHUNK, H, d) * (d ** -0.5)
    v = v.reshape(B, N, CHUNK, H, d)
    log_g = jnp.log1p(-(2.0 ** (-RET_DECAY_BASE - jnp.arange(H, dtype=jnp.float32))))
    pos = jnp.arange(CHUNK, dtype=jnp.float32)
    diff = pos[:, None] - pos[None, :]
    intra_decay = jnp.where(diff[None] >= 0,
                            jnp.exp(log_g[:, None, None] * jnp.maximum(diff, 0.0)[None]), 0.0)
    scores = jnp.einsum('bnihd,bnjhd->bnhij', q, k) * intra_decay
    intra = jnp.einsum('bnhij,bnjhe->bnihe', scores, v)
    tail = jnp.exp(log_g[None, :] * (CHUNK - 1.0 - pos)[:, None])
    kv = jnp.einsum('bnjhd,bnjhe->nbhde', k * tail[None, None, :, :, None], v)
    chunk_decay = jnp.exp(log_g * CHUNK)[None, :, None, None]

    def step(state, kv_n):
        return state * chunk_decay + kv_n, state

    _, s_prev = lax.scan(step, jnp.zeros_like(kv[0]), kv)
    head = jnp.exp(log_g[None, :] * (pos + 1.0)[:, None])
    cross = jnp.einsum('bnihd,nbhde->bnihe', q * head[None, None, :, :, None], s_prev)
    return (intra + cross).reshape(B, T, H, d)


def spatial_gating(z, ln_g, ln_b, w_s, b_s):
    B, T, _ = z.shape
    N = T // CHUNK
    u, v = jnp.split(z.astype(jnp.float32), 2, axis=-1)
    mu = jnp.mean(v, axis=-1, keepdims=True)
    var = jnp.mean(jnp.square(v - mu), axis=-1, keepdims=True)
    v = (v - mu) * lax.rsqrt(var + NORM_EPS) * ln_g.astype(jnp.float32) + ln_b.astype(jnp.float32)
    vb = v.reshape(B, N, CHUNK, MLP_GROUPS, HEAD_DIM)
    causal = jnp.tril(jnp.ones((CHUNK, CHUNK), jnp.float32))
    ws = w_s.astype(jnp.float32) * causal[None]
    mixed = jnp.einsum('gij,bnjgc->bnigc', ws, vb) + b_s.astype(jnp.float32).T[None, None, :, :, None]
    return u * mixed.reshape(B, T, MLP_WIDTH)


def sliding_window_attention(q, k, v, sinks):
    B, T, H, d = q.shape
    Hkv = k.shape[2]
    G = H // Hkv
    N = T // CHUNK
    qb = q.astype(jnp.float32).reshape(B, N, CHUNK, Hkv, G, d) * (d ** -0.5)

    def band(t):
        tb = t.astype(jnp.float32).reshape(B, N, CHUNK, Hkv, d)
        prev = jnp.pad(tb, ((0, 0), (1, 0), (0, 0), (0, 0), (0, 0)))[:, :-1]
        return jnp.concatenate([prev, tb], axis=2)

    kb, vb = band(k), band(v)
    s = jnp.einsum('bnqhgd,bnkhd->bhgnqk', qb, kb)
    qi = jnp.arange(CHUNK)
    kj = jnp.arange(2 * CHUNK)
    dist = CHUNK + qi[:, None] - kj[None, :]
    key_pos = jnp.arange(N)[:, None] * CHUNK - CHUNK + kj[None, :]
    allowed = ((dist >= 0) & (dist < WINDOW))[None] & (key_pos >= 0)[:, None, :]
    slopes = alibi_slopes(H).reshape(Hkv, G)
    s = s - slopes[:, :, None, None, None] * dist.astype(jnp.float32)
    s = jnp.where(allowed, s, -jnp.inf)
    sink = jnp.broadcast_to(sinks.astype(jnp.float32).reshape(1, Hkv, G, 1, 1, 1), s.shape[:-1] + (1,))
    p = jax.nn.softmax(jnp.concatenate([s, sink], axis=-1), axis=-1)[..., :-1]
    out = jnp.einsum('bhgnqk,bnkhd->bnqhgd', p, vb)
    return out.reshape(B, T, H, d)


def setup_inputs(seed: int = 0) -> dict:
    key = jax.random.key(seed)
    ks = jax.random.split(key, 16)
    f32 = jnp.float32

    def nrm(k, shape, scale):
        return jax.random.normal(k, shape, f32) * scale

    return {
        "x": nrm(ks[0], (BATCH, SEQ, D_MODEL), 1.0),
        "norm1_g": 1.0 + nrm(ks[1], (DEPTH, D_MODEL), 0.02),
        "w_in": nrm(ks[2], (DEPTH, D_MODEL, IN_WIDTH), D_MODEL ** -0.5),
        "ret_norm_g": 1.0 + nrm(ks[3], (DEPTH, RET_WIDTH), 0.02),
        "mlp_ln_g": 1.0 + nrm(ks[4], (DEPTH, MLP_WIDTH), 0.02),
        "mlp_ln_b": nrm(ks[5], (DEPTH, MLP_WIDTH), 0.02),
        "w_spatial": nrm(ks[6], (DEPTH, MLP_GROUPS, CHUNK, CHUNK), CHUNK ** -0.5),
        "b_spatial": 1.0 + nrm(ks[7], (DEPTH, MLP_GROUPS, CHUNK), 0.02),
        "attn_sinks": nrm(ks[8], (DEPTH, ATT_HEADS), 0.5),
        "w_out": nrm(ks[9], (DEPTH, MIX_WIDTH, D_MODEL), MIX_WIDTH ** -0.5),
        "norm2_g": 1.0 + nrm(ks[10], (DEPTH, D_MODEL), 0.02),
        "w_ffn_in": nrm(ks[11], (DEPTH, D_MODEL, 2 * D_FF), D_MODEL ** -0.5),
        "w_ffn_out": nrm(ks[12], (DEPTH, D_FF, D_MODEL), D_FF ** -0.5),
        "final_norm_g": 1.0 + nrm(ks[13], (D_MODEL,), 0.02),
    }


def reference(x, norm1_g, w_in, ret_norm_g, mlp_ln_g, mlp_ln_b, w_spatial, b_spatial,
              attn_sinks, w_out, norm2_g, w_ffn_in, w_ffn_out, final_norm_g):
    B, T, _ = x.shape
    sizes = [RET_WIDTH] * 4 + [2 * MLP_WIDTH] + [ATT_WIDTH, ATT_KV_WIDTH, ATT_KV_WIDTH]
    split_idx = np.cumsum(sizes)[:-1].tolist()
    for l in range(DEPTH):
        h = rms_norm(x, norm1_g[l])
        proj = h @ w_in[l]
        q_r, k_r, v_r, g_r, z_m, q_a, k_a, v_a = jnp.split(proj, split_idx, axis=-1)

        ret = retention(q_r.astype(jnp.float32).reshape(B, T, RET_HEADS, HEAD_DIM),
                        k_r.astype(jnp.float32).reshape(B, T, RET_HEADS, HEAD_DIM),
                        v_r.astype(jnp.float32).reshape(B, T, RET_HEADS, HEAD_DIM))
        ret = ret * lax.rsqrt(jnp.mean(ret * ret, axis=-1, keepdims=True) + NORM_EPS)
        ret = ret.reshape(B, T, RET_WIDTH) * ret_norm_g[l].astype(jnp.float32)
        ret_out = (jax.nn.silu(g_r.astype(jnp.float32)) * ret).astype(x.dtype)

        mlp_out = spatial_gating(jax.nn.gelu(z_m, approximate=False), mlp_ln_g[l], mlp_ln_b[l],
                                 w_spatial[l], b_spatial[l]).astype(x.dtype)

        att = sliding_window_attention(q_a.reshape(B, T, ATT_HEADS, HEAD_DIM),
                                       k_a.reshape(B, T, ATT_KV_HEADS, HEAD_DIM),
                                       v_a.reshape(B, T, ATT_KV_HEADS, HEAD_DIM),
                                       attn_sinks[l])
        att_out = att.reshape(B, T, ATT_WIDTH).astype(x.dtype)

        mixed = jnp.concatenate([ret_out, mlp_out, att_out], axis=-1)
        x = x + mixed @ w_out[l]

        h = rms_norm(x, norm2_g[l])
        a, b = jnp.split(h @ w_ffn_in[l], 2, axis=-1)
        x = x + (jax.nn.silu(a) * b) @ w_ffn_out[l]
    return rms_norm(x, final_norm_g)
```

```cpp
#include <hip/hip_runtime.h>
#include <hip/hip_cooperative_groups.h>
#include <cstdio>
#include <cstdint>
namespace cg = cooperative_groups;
namespace pg8 {
#define PG8_LAS __attribute__((address_space(3)))
typedef unsigned short bf16_t;
typedef short bf16x8 __attribute__((ext_vector_type(8)));
typedef float f32x4 __attribute__((ext_vector_type(4)));
typedef unsigned u32x4 __attribute__((ext_vector_type(4)));
constexpr int BM = 256, BK = 64, HALF = 128, HTB = HALF * BK * 2  , STAGE_BYTES = 8 * HTB, NXCD = 8, WGM = 2;

__host__ __device__ __forceinline__ int lds_byte(int r, int c) { const int st = (r >> 4) * 2 + (c >> 5), rr = r & 15, cc = c & 31, ob = rr * 64 + cc * 2; return st * 1024 + (ob ^ (((ob >> 9) & 1) << 5)); }
__host__ __device__ __forceinline__ void stage_rc(int b, int& R, int& C) { const int st = b / 1024, sb = b % 1024, swz = sb ^ (((sb >> 9) & 1) << 5); R = (st >> 1) * 16 + swz / 64; C = (st & 1) * 32 + (swz % 64) / 2; }
__host__ __device__ __forceinline__ int perm32(int rho) { const int n = rho >> 4, i = rho & 15; return 8 * (i >> 2) + 4 * n + (i & 3); }

struct Unit { int pm, pn; };
struct Gemm { const bf16_t* A; const bf16_t* Bt; int M, N, K; };

struct StaticOrder {
    int nM, nN, nwg, G, c;
    __host__ __device__ void init(int M, int N, int G_, int c_) { nM = M / BM; nN = N / BM; nwg = nM * nN; G = G_; c = c_; }
    __host__ __device__ bool next(int i, Unit& u) const {
        const long L = (long)i * G + c; if (L >= nwg) return false;
        int wgid = (int)L; { const int q = nwg / NXCD, r = nwg % NXCD, xcd = wgid % NXCD, off = wgid / NXCD; wgid = (xcd < r ? xcd * (q + 1) : r * (q + 1) + (xcd - r) * q) + off; }
        const int nig = WGM * nN, gid = wgid / nig, fm = gid * WGM, gsz = (nM - fm) < WGM ? (nM - fm) : WGM;
        u.pm = fm + ((wgid % nig) % gsz); u.pn = (wgid % nig) / gsz; return true;
    }
    __device__ __forceinline__ void a_ready(const Unit&) const {}
    __device__ __forceinline__ void done(const Unit&) const {}
};
__device__ __forceinline__ unsigned cvt_pk_bf16(float lo, float hi) { unsigned r; asm volatile("v_cvt_pk_bf16_f32 %0, %1, %2" : "=v"(r) : "v"(lo), "v"(hi)); return r; }
typedef float f32x2 __attribute__((ext_vector_type(2)));
__device__ __forceinline__ f32x2 gelu_pk(f32x2 v) {
    const f32x2 av = __builtin_elementwise_abs(v), d = av * 0.2316418882f + 1.0f;
    f32x2 t; t.x = __builtin_amdgcn_rcpf(d.x); t.y = __builtin_amdgcn_rcpf(d.y);
    f32x2 q = t * 0.5307027145f + (-0.7265760135f); q = q * t + 0.7107068705f; q = q * t + (-0.142248368f); q = q * t + 0.127414796f; q = q * t;
    const f32x2 s = (v * v) * (-0.72134752044f);
    f32x2 e; e.x = __builtin_amdgcn_exp2f(s.x); e.y = __builtin_amdgcn_exp2f(s.y);
    const f32x2 m = v * (q * e), r = v - m;
    f32x2 o; o.x = v.x < 0.f ? m.x : r.x; o.y = v.y < 0.f ? m.y : r.y; return o;
}
template <class Epi, class Sched, bool ALIGN_EPI = false, bool SP2 = false>
__device__ __forceinline__ void gemm_phase(PG8_LAS unsigned char* lds, const Gemm g, const Sched& S, const Epi& E) {
    int tid_ = threadIdx.x; asm volatile("" : "+v"(tid_));
    const int tid = tid_, wid = __builtin_amdgcn_readfirstlane(tid >> 6), lane = tid & 63, wr = wid >> 2, wc = wid & 3, fr = lane & 15, fq = lane >> 4;
    const int K = g.K, nt = K / BK;
    unsigned voffA[2], voffB[2];
#pragma unroll
    for (int i = 0; i < 2; ++i) { int R, C; stage_rc(tid * 16 + i * 8192, R, C); const int Rb = Epi::PERM ? ((R & ~31) + perm32(R & 31)) : R;
        voffA[i] = (unsigned)(R * K + C) * 2u; voffB[i] = (unsigned)(Rb * K + C) * 2u; }
    const size_t kstep = (size_t)(BK * 2);
    const size_t hstep = (size_t)HALF * K * 2;
    const size_t tstep = 2 * hstep;
    const unsigned ldsw = (unsigned)wid * 1024u;
    const int aoff = lds_byte(wr * 64 + fr, fq * 8), boff = lds_byte(wc * 32 + fr, fq * 8);
#define PG8_SA(b, h) (((b) * 2 + (h)) * HTB)
#define PG8_SB(b, h) ((4 + (b) * 2 + (h)) * HTB)
#define PG8_STAGE(bufoff, gbase, voff) do { _Pragma("unroll") for (int _i = 0; _i < 2; ++_i) \
        __builtin_amdgcn_global_load_lds((const unsigned*)((const char*)(gbase) + (voff)[_i]), (PG8_LAS unsigned*)(lds + (bufoff) + ldsw + _i * 8192), 16, 0, 0); } while (0)
#define PG8_LDA(dst, b, h) do { _Pragma("unroll") for (int m = 0; m < 4; ++m) _Pragma("unroll") for (int k = 0; k < 2; ++k) dst[m][k] = *(const PG8_LAS bf16x8*)(lds + PG8_SA(b, h) + aoff + m * 2048 + k * 1024); } while (0)
#define PG8_LDB(dst, b, h) do { _Pragma("unroll") for (int n = 0; n < 2; ++n) _Pragma("unroll") for (int k = 0; k < 2; ++k) dst[n][k] = *(const PG8_LAS bf16x8*)(lds + PG8_SB(b, h) + boff + n * 2048 + k * 1024); } while (0)
#define PG8_MMA(ai, bj, At, Bt) do { __builtin_amdgcn_s_setprio(1); _Pragma("unroll") for (int m = 0; m < 4; ++m) _Pragma("unroll") for (int n = 0; n < 2; ++n) _Pragma("unroll") for (int k = 0; k < 2; ++k) \
        acc[ai][bj][m][n] = __builtin_amdgcn_mfma_f32_16x16x32_bf16(Bt[n][k], At[m][k], acc[ai][bj][m][n], 0, 0, 0); __builtin_amdgcn_s_setprio(0); } while (0)
#define PG8_WAIT_V(n) asm volatile("s_waitcnt vmcnt(" #n ")" ::: "memory")
#define PG8_WAIT_L(n) asm volatile("s_waitcnt lgkmcnt(" #n ")" ::: "memory")
#define PG8_BAR __builtin_amdgcn_s_barrier()
#define PG8_SCHED __builtin_amdgcn_sched_barrier(0)
    Unit cur, nxt; int ui = 0;
    if (!S.next(0, cur)) return;
    f32x4 acc[2][2][4][2];
#pragma unroll
    for (int a = 0; a < 2; ++a)
#pragma unroll
        for (int b = 0; b < 2; ++b)
#pragma unroll
            for (int m = 0; m < 4; ++m)
#pragma unroll
                for (int n = 0; n < 2; ++n) acc[a][b][m][n] = (f32x4){0.f, 0.f, 0.f, 0.f};
    bf16x8 At[4][2], B0[2][2], B1[2][2];
    const char* cA = (const char*)g.A + (size_t)cur.pm * tstep; const char* cB = (const char*)g.Bt + (size_t)cur.pn * tstep;
    S.a_ready(cur);
    if constexpr (SP2) {
        PG8_STAGE(PG8_SB(0, 0), cB, voffB); PG8_STAGE(PG8_SB(0, 1), cB + hstep, voffB); PG8_STAGE(PG8_SA(0, 0), cA, voffA); PG8_STAGE(PG8_SA(0, 1), cA + hstep, voffA);
        if (wr == 1) PG8_BAR;
        PG8_WAIT_V(2); PG8_BAR;
        PG8_STAGE(PG8_SB(1, 0), cB + kstep, voffB); PG8_STAGE(PG8_SA(1, 0), cA + kstep, voffA); PG8_STAGE(PG8_SB(1, 1), cB + hstep + kstep, voffB);
        PG8_WAIT_V(6); PG8_BAR;
    } else {
        PG8_STAGE(PG8_SB(0, 0), cB, voffB); PG8_STAGE(PG8_SA(0, 0), cA, voffA); PG8_STAGE(PG8_SB(0, 1), cB + hstep, voffB); PG8_STAGE(PG8_SA(0, 1), cA + hstep, voffA);
        if (wr == 1) PG8_BAR;
        PG8_WAIT_V(4); PG8_BAR;
        PG8_STAGE(PG8_SB(1, 0), cB + kstep, voffB); PG8_STAGE(PG8_SA(1, 0), cA + kstep, voffA); PG8_STAGE(PG8_SB(1, 1), cB + hstep + kstep, voffB);
        PG8_WAIT_V(6); PG8_BAR;
    }
    for (;;) {
        const bool has_next = S.next(ui + 1, nxt);
        const char* nA = has_next ? (const char*)g.A + (size_t)nxt.pm * tstep : cA; const char* nB = has_next ? (const char*)g.Bt + (size_t)nxt.pn * tstep : cB;
        for (int t = 0; t < nt; t += 2) {
            const bool last = (t == nt - 2);
            const char* a1 = cA + (size_t)(t + 1) * kstep;
            const char* a2 = last ? nA : cA + (size_t)(t + 2) * kstep; const char* b2 = last ? nB : cB + (size_t)(t + 2) * kstep;
            const char* a3 = a2 + kstep; const char* b3 = b2 + kstep;
            if (last && has_next) S.a_ready(nxt);
            if constexpr (SP2) {
            PG8_LDB(B0, 0, 0); PG8_LDB(B1, 0, 1); PG8_SCHED; PG8_LDA(At, 0, 0); PG8_STAGE(PG8_SA(1, 1), a1 + hstep, voffA);
            PG8_WAIT_V(8); PG8_WAIT_L(0); PG8_BAR; PG8_MMA(0, 0, At, B0); PG8_MMA(0, 1, At, B1); PG8_BAR; PG8_SCHED;
            PG8_LDA(At, 0, 1); PG8_STAGE(PG8_SB(0, 0), b2, voffB); PG8_STAGE(PG8_SB(0, 1), b2 + hstep, voffB); PG8_STAGE(PG8_SA(0, 0), a2, voffA);
            PG8_WAIT_V(8); PG8_WAIT_L(0); PG8_BAR; PG8_MMA(1, 0, At, B0); PG8_MMA(1, 1, At, B1); PG8_BAR; PG8_SCHED;
            PG8_LDB(B0, 1, 0); PG8_LDB(B1, 1, 1); PG8_SCHED; PG8_LDA(At, 1, 0); PG8_STAGE(PG8_SA(0, 1), a2 + hstep, voffA);
            PG8_WAIT_V(8); PG8_WAIT_L(0); PG8_BAR; PG8_MMA(0, 0, At, B0); PG8_MMA(0, 1, At, B1); PG8_BAR; PG8_SCHED;
            PG8_LDA(At, 1, 1); PG8_STAGE(PG8_SB(1, 0), b3, voffB); PG8_STAGE(PG8_SB(1, 1), b3 + hstep, voffB); PG8_STAGE(PG8_SA(1, 0), a3, voffA);
            PG8_WAIT_V(8); PG8_WAIT_L(0); PG8_BAR; PG8_MMA(1, 0, At, B0); PG8_MMA(1, 1, At, B1); PG8_BAR; PG8_SCHED;
            } else {
            PG8_LDB(B0, 0, 0); PG8_SCHED; PG8_LDA(At, 0, 0); PG8_STAGE(PG8_SA(1, 1), a1 + hstep, voffA);
            PG8_WAIT_L(8); PG8_BAR; PG8_WAIT_L(0); PG8_MMA(0, 0, At, B0); PG8_BAR; PG8_SCHED;
            PG8_LDB(B1, 0, 1); PG8_STAGE(PG8_SB(0, 0), b2, voffB);
            PG8_BAR; PG8_WAIT_L(0); PG8_MMA(0, 1, At, B1); PG8_BAR;
            PG8_LDA(At, 0, 1); PG8_STAGE(PG8_SA(0, 0), a2, voffA);
            PG8_BAR; PG8_WAIT_L(0); PG8_MMA(1, 0, At, B0); PG8_BAR; PG8_SCHED;
            PG8_STAGE(PG8_SB(0, 1), b2 + hstep, voffB);
            PG8_WAIT_V(6); PG8_BAR; PG8_MMA(1, 1, At, B1); PG8_BAR;
            PG8_LDB(B0, 1, 0); PG8_SCHED; PG8_LDA(At, 1, 0); PG8_STAGE(PG8_SA(0, 1), a2 + hstep, voffA);
            PG8_WAIT_L(8); PG8_BAR; PG8_WAIT_L(0); PG8_MMA(0, 0, At, B0); PG8_BAR; PG8_SCHED;
            PG8_LDB(B1, 1, 1); PG8_STAGE(PG8_SB(1, 0), b3, voffB);
            PG8_BAR; PG8_WAIT_L(0); PG8_MMA(0, 1, At, B1); PG8_BAR;
            PG8_LDA(At, 1, 1); PG8_STAGE(PG8_SA(1, 0), a3, voffA);
            PG8_BAR; PG8_WAIT_L(0); PG8_MMA(1, 0, At, B0); PG8_BAR; PG8_SCHED;
            PG8_STAGE(PG8_SB(1, 1), b3 + hstep, voffB);
            PG8_WAIT_V(6); PG8_BAR; PG8_MMA(1, 1, At, B1); PG8_BAR;
            }
        }
        if constexpr (ALIGN_EPI) { if (wr == 0) PG8_BAR; }
        if constexpr (!Epi::AFTER_DRAIN) { E(acc, cur, ui, wr, wc, fr, fq); S.done(cur); }
        if (!has_next) break;
#pragma unroll
        for (int a = 0; a < 2; ++a)
#pragma unroll
            for (int b = 0; b < 2; ++b)
#pragma unroll
                for (int m = 0; m < 4; ++m)
#pragma unroll
                    for (int n = 0; n < 2; ++n) acc[a][b][m][n] = (f32x4){0.f, 0.f, 0.f, 0.f};
        cur = nxt; cA = nA; cB = nB; ++ui;
        if constexpr (ALIGN_EPI) { if (wr == 1) PG8_BAR; }
    }
    PG8_WAIT_V(0);
    if constexpr (!ALIGN_EPI) { if (wr == 0) PG8_BAR; }
    PG8_BAR;
    if constexpr (Epi::AFTER_DRAIN) { E.fused(acc, cur, wr, wc, fr, fq, lds, wid, lane); S.done(cur); }
#undef PG8_SA
#undef PG8_SB
#undef PG8_STAGE
#undef PG8_LDA
#undef PG8_LDB
#undef PG8_MMA
#undef PG8_WAIT_V
#undef PG8_WAIT_L
#undef PG8_BAR
#undef PG8_SCHED
}
}


#define LAS __attribute__((address_space(3)))
#define GAS __attribute__((address_space(1)))
using pg8::bf16_t; using pg8::bf16x8; using pg8::f32x4; using pg8::u32x4; using pg8::cvt_pk_bf16; using pg8::f32x2; using pg8::gelu_pk;
typedef short s16x4 __attribute__((ext_vector_type(4)));
typedef short v4i16_t __attribute__((ext_vector_type(4)));
typedef unsigned u32x2 __attribute__((ext_vector_type(2)));
constexpr int NB = 4, T = 4096, M = NB * T, D = 1024, NL = 4;
constexpr int NIN = 2688, NPROJ = 2816, DFF = 2816, NCH = 32;
constexpr int C_QR = 0, C_KR = 384, C_VR = 768, C_GR = 1152, C_U = 1536, C_V = 1792, C_QA = 2048, C_KA = 2432, C_VA = 2560;
constexpr int MIX_RET = 0, MIX_MLP = 384, MIX_ATT = 640;
constexpr float EPS = 1e-6f;
constexpr size_t MiB = 1u << 20;
constexpr size_t WS_W1 = 1 * MiB, WS_W2 = 23 * MiB, WS_W3 = 31 * MiB, WS_W4 = 75 * MiB, WS_WSP = 97 * MiB, WS_SSQ = 98 * MiB, WS_KV = 99 * MiB,
                 WS_XB = 111 * MiB, WS_MIX = 143 * MiB, WS_PROJ = 175 * MiB, WS_END = 265 * MiB;
constexpr int LDS_BYTES = 147456, RTAB_OFF = 131072;
constexpr int CONV_IL = 16 * 44 + 16 * 16 + 16 * 88 + 44 * 16, CONV_SPLIT = 16 * 44 + 16 * 16;
constexpr int CONV_FIRST_WG = (64 * 22) % 256;

struct Args { const float* in[14]; float* out; unsigned char* ws; };

__device__ __forceinline__ float wave_sum(float v) {
#pragma unroll
    for (int o = 1; o < 64; o <<= 1) v += __shfl_xor(v, o);
    return v;
}
__device__ __forceinline__ void lds_barrier() { asm volatile("s_waitcnt lgkmcnt(0)" ::: "memory"); __builtin_amdgcn_s_barrier(); asm volatile("" ::: "memory"); }
template <int CTRL> __device__ __forceinline__ float dppf(float x) { return __builtin_bit_cast(float, __builtin_amdgcn_update_dpp(0, __builtin_bit_cast(int, x), CTRL, 0xf, 0xf, true)); }
__device__ __forceinline__ void wave_sum2(float& a, float& b) {
    a += dppf<0xB1>(a); b += dppf<0xB1>(b);
    a += dppf<0x4E>(a); b += dppf<0x4E>(b);
    a += dppf<0x141>(a); b += dppf<0x141>(b);
    a += dppf<0x140>(a); b += dppf<0x140>(b);
    a += __shfl_xor(a, 16); b += __shfl_xor(b, 16);
    a += __shfl_xor(a, 32); b += __shfl_xor(b, 32);
}
__device__ __forceinline__ float bf2f(unsigned short b) { return __uint_as_float(((unsigned)b) << 16); }
__device__ __forceinline__ f32x4 mfma16(bf16x8 a, bf16x8 b, f32x4 c) { return __builtin_amdgcn_mfma_f32_16x16x32_bf16(a, b, c, 0, 0, 0); }
__device__ __forceinline__ s16x4 tr_read(const LAS unsigned char* p) { return __builtin_bit_cast(s16x4, __builtin_amdgcn_ds_read_tr16_b64_v4i16((LAS v4i16_t*)p)); }
__device__ __forceinline__ bf16x8 mk8(s16x4 lo, s16x4 hi) { return (bf16x8){lo[0], lo[1], lo[2], lo[3], hi[0], hi[1], hi[2], hi[3]}; }
__device__ __forceinline__ bf16x8 pack8(f32x4 a, f32x4 b) { u32x4 w; w.x = cvt_pk_bf16(a[0], a[1]); w.y = cvt_pk_bf16(a[2], a[3]); w.z = cvt_pk_bf16(b[0], b[1]); w.w = cvt_pk_bf16(b[2], b[3]); return __builtin_bit_cast(bf16x8, w); }
__device__ __forceinline__ u32x2 pack4(f32x4 a) { u32x2 w; w.x = cvt_pk_bf16(a[0], a[1]); w.y = cvt_pk_bf16(a[2], a[3]); return w; }
__device__ __forceinline__ f32x4 unpack4(u32x2 w) { return (f32x4){__uint_as_float(w.x << 16), __uint_as_float(w.x & 0xffff0000u), __uint_as_float(w.y << 16), __uint_as_float(w.y & 0xffff0000u)}; }

struct EpiProj {
    static constexpr bool PERM = true, AFTER_DRAIN = false;
    GAS bf16_t* O; const LAS float* rtab;
    __device__ __forceinline__ void operator()(const f32x4 (&acc)[2][2][4][2], const pg8::Unit& u, int ui, int wr, int wc, int fr, int fq) const {
        const int row0 = u.pm * 256 + wr * 64 + fr, col0 = u.pn * 256 + wc * 32 + 8 * fq;
        const bool gl = (u.pn == 6 || u.pn == 7);
#pragma unroll
        for (int ai = 0; ai < 2; ++ai)
#pragma unroll
            for (int m = 0; m < 4; ++m) {
                const float rs = rtab[ui * 256 + wr * 64 + fr + ai * 128 + m * 16];
                GAS bf16_t* rowp = O + (size_t)(row0 + ai * 128 + m * 16) * NPROJ + col0;
#pragma unroll
                for (int bj = 0; bj < 2; ++bj) {
                    f32x4 v0 = acc[ai][bj][m][0] * rs, v1 = acc[ai][bj][m][1] * rs;
                    if (gl) { f32x2 a = gelu_pk((f32x2){v0[0], v0[1]}), b = gelu_pk((f32x2){v0[2], v0[3]}), c = gelu_pk((f32x2){v1[0], v1[1]}), d = gelu_pk((f32x2){v1[2], v1[3]});
                        v0 = (f32x4){a.x, a.y, b.x, b.y}; v1 = (f32x4){c.x, c.y, d.x, d.y}; }
                    u32x4 w; w.x = cvt_pk_bf16(v0[0], v0[1]); w.y = cvt_pk_bf16(v0[2], v0[3]); w.z = cvt_pk_bf16(v1[0], v1[1]); w.w = cvt_pk_bf16(v1[2], v1[3]);
                    *(GAS u32x4*)(rowp + bj * 128) = w;
                }
            }
    }
};
struct EpiSwiGLU {
    static constexpr bool PERM = true, AFTER_DRAIN = false;
    GAS bf16_t* O; const LAS float* rtab;
    __device__ __forceinline__ void operator()(const f32x4 (&acc)[2][2][4][2], const pg8::Unit& u, int ui, int wr, int wc, int fr, int fq) const {
        const int row0 = u.pm * 256 + wr * 64 + fr, col0 = u.pn * 128 + wc * 32 + 8 * fq;
#pragma unroll
        for (int ai = 0; ai < 2; ++ai)
#pragma unroll
            for (int m = 0; m < 4; ++m) {
                const float rs = rtab[ui * 256 + wr * 64 + fr + ai * 128 + m * 16];
                f32x4 h[2];
#pragma unroll
                for (int n = 0; n < 2; ++n) {
                    const f32x4 a = acc[ai][0][m][n] * rs, b = acc[ai][1][m][n] * rs;
#pragma unroll
                    for (int j = 0; j < 4; ++j) h[n][j] = a[j] * b[j] * __builtin_amdgcn_rcpf(1.0f + __expf(-a[j]));
                }
                u32x4 w; w.x = cvt_pk_bf16(h[0][0], h[0][1]); w.y = cvt_pk_bf16(h[0][2], h[0][3]); w.z = cvt_pk_bf16(h[1][0], h[1][1]); w.w = cvt_pk_bf16(h[1][2], h[1][3]);
                *(GAS u32x4*)(O + (size_t)(row0 + ai * 128 + m * 16) * DFF + col0) = w;
            }
    }
};
struct EpiResid {
    static constexpr bool PERM = true, AFTER_DRAIN = false;
    GAS bf16_t* xb; GAS float* ssq;
    __device__ __forceinline__ void operator()(const f32x4 (&acc)[2][2][4][2], const pg8::Unit& u, int ui, int wr, int wc, int fr, int fq) const {
        const int row0 = u.pm * 256 + wr * 64 + fr, col0 = u.pn * 256 + wc * 32 + 8 * fq;
#pragma unroll
        for (int ai = 0; ai < 2; ++ai) {
            u32x4 w[4][2];
#pragma unroll
            for (int m = 0; m < 4; ++m)
#pragma unroll
                for (int bj = 0; bj < 2; ++bj) w[m][bj] = *(const GAS u32x4*)(xb + (size_t)(row0 + ai * 128 + m * 16) * D + col0 + bj * 128);
#pragma unroll
            for (int m = 0; m < 4; ++m) {
                const int row = row0 + ai * 128 + m * 16; const size_t off = (size_t)row * D + col0; float q = 0.f;
#pragma unroll
                for (int bj = 0; bj < 2; ++bj) {
                    const f32x4 o0 = unpack4((u32x2){w[m][bj].x, w[m][bj].y}) + acc[ai][bj][m][0], o1 = unpack4((u32x2){w[m][bj].z, w[m][bj].w}) + acc[ai][bj][m][1];
                    *(GAS bf16x8*)(xb + off + bj * 128) = pack8(o0, o1);
                    q += ((o0[0] * o0[0] + o0[1] * o0[1]) + (o0[2] * o0[2] + o0[3] * o0[3])) + ((o1[0] * o1[0] + o1[1] * o1[1]) + (o1[2] * o1[2] + o1[3] * o1[3]));
                }
                q += __shfl_xor(q, 16); q += __shfl_xor(q, 32);
                if (fq == 0) ssq[(size_t)(u.pn * 4 + wc) * M + row] = q;
            }
            asm volatile("" ::: "memory");
        }
    }
};

__device__ __forceinline__ void build_rtab(LAS float* rtab, const pg8::StaticOrder& S, const GAS float* ssq, int tid) {
    float p[3][16]; bool ok[3];
#pragma unroll
    for (int k = 0; k < 3; ++k) { const int idx = tid + 512 * k; pg8::Unit u; ok[k] = S.next(idx >> 8, u);
        if (ok[k]) { const int row = u.pm * 256 + (idx & 255);
#pragma unroll
            for (int j = 0; j < 16; ++j) p[k][j] = ssq[(size_t)j * M + row]; } }
#pragma unroll
    for (int k = 0; k < 3; ++k) if (ok[k]) { float s = 0.f;
#pragma unroll
        for (int j = 0; j < 16; ++j) s += p[k][j];
        rtab[tid + 512 * k] = rsqrtf(s * (1.0f / D) + EPS); }
    for (int idx = tid + 1536; idx < 16 * 256; idx += 512) {
        pg8::Unit u; if (!S.next(idx >> 8, u)) break;
        const int row = u.pm * 256 + (idx & 255); float s = 0.f;
#pragma unroll
        for (int j = 0; j < 16; ++j) s += ssq[(size_t)j * M + row];
        rtab[idx] = rsqrtf(s * (1.0f / D) + EPS);
    }
    __syncthreads();
}

constexpr int TS = 136;
__device__ __forceinline__ void transpose_item(const GAS float* W, int N, int K, int srccol0, float cscale, const GAS float* gk, GAS bf16_t* WT, int drow0, int k0, LAS unsigned char* scr, int lane) {
    const int g4 = lane >> 4, i16 = lane & 15;
    if (srccol0 < 0) {
        const u32x4 z = (u32x4){0u, 0u, 0u, 0u};
#pragma unroll
        for (int nb = 0; nb < 4; ++nb) { GAS bf16_t* o = WT + (size_t)(drow0 + nb * 16 + i16) * K + k0 + 16 * g4; *(GAS u32x4*)o = z; *(GAS u32x4*)(o + 8) = z; }
        return;
    }
    f32x4 v[16];
#pragma unroll
    for (int it = 0; it < 16; ++it) v[it] = *(const GAS f32x4*)(W + (size_t)(k0 + 4 * it + g4) * N + srccol0 + 4 * i16);
#pragma unroll
    for (int it = 0; it < 16; ++it) { const float sc = gk ? gk[k0 + 4 * it + g4] * cscale : cscale;
        *(LAS u32x2*)(scr + (4 * it + g4) * TS + i16 * 8) = pack4(v[it] * sc); }
    asm volatile("s_waitcnt lgkmcnt(0)" ::: "memory");
#pragma unroll
    for (int nb = 0; nb < 4; ++nb) {
        const LAS unsigned char* p = scr + (16 * g4 + (i16 >> 2)) * TS + (nb * 16 + 4 * (i16 & 3)) * 2;
        const s16x4 r0 = tr_read(p), r1 = tr_read(p + 4 * TS), r2 = tr_read(p + 8 * TS), r3 = tr_read(p + 12 * TS);
        GAS bf16_t* o = WT + (size_t)(drow0 + nb * 16 + i16) * K + k0 + 16 * g4;
        *(GAS bf16x8*)o = mk8(r0, r1); *(GAS bf16x8*)(o + 8) = mk8(r2, r3);
    }
    asm volatile("s_waitcnt lgkmcnt(0)" ::: "memory");
}

__device__ __forceinline__ void convert_layer_items(const GAS float* n1g, const GAS float* win, const GAS float* wout, const GAS float* n2g, const GAS float* wfi, const GAS float* wfo, GAS unsigned char* ws, int l, int first, int stride, LAS unsigned char* scr, int lane, int lo = 0, int hi = CONV_IL) {
    constexpr int I1 = 16 * 44, I2 = 16 * 16, I3 = 16 * 88, I4 = 44 * 16;
    for (int it = lo + first; it < hi; it += stride) {
        int r = it;
        if (r < I1) { const int kb = r / 44, nb = r % 44, n0 = 64 * nb;
            const float cs = ((n0 >= C_KR && n0 < C_VR) || (n0 >= C_QA && n0 < C_KA)) ? 0.125f : 1.0f;
            transpose_item(win + (size_t)l * D * NIN, NIN, D, n0 < NIN ? n0 : -1, cs, n1g + l * D, (GAS bf16_t*)(ws + WS_W1) + (size_t)l * NPROJ * D, n0, 64 * kb, scr, lane); continue; }
        r -= I1;
        if (r < I2) { const int kb = r / 16, nb = r % 16;
            transpose_item(wout + (size_t)l * D * D, D, D, 64 * nb, 1.0f, nullptr, (GAS bf16_t*)(ws + WS_W2) + (size_t)l * D * D, 64 * nb, 64 * kb, scr, lane); continue; }
        r -= I2;
        if (r < I3) { const int kb = r / 88, nb = r % 88, n0 = 64 * nb, pn = n0 >> 8, bj = (n0 >> 7) & 1, j = n0 & 127;
            transpose_item(wfi + (size_t)l * D * 2 * DFF, 2 * DFF, D, bj * DFF + 128 * pn + j, 1.0f, n2g + l * D, (GAS bf16_t*)(ws + WS_W3) + (size_t)l * 2 * DFF * D, n0, 64 * kb, scr, lane); continue; }
        r -= I3;
        { const int kb = r / 16, nb = r % 16;
            transpose_item(wfo + (size_t)l * DFF * D, D, DFF, 64 * nb, 1.0f, nullptr, (GAS bf16_t*)(ws + WS_W4) + (size_t)l * D * DFF, 64 * nb, 64 * kb, scr, lane); }
    }
}

__device__ __forceinline__ void prologue(const Args& a, LAS unsigned char* lds, int tid) {
    const int lane = tid & 63, wave = tid >> 6, G = gridDim.x;
    const int gw = blockIdx.x * 8 + wave, NGW = G * 8;
    GAS unsigned char* ws = (GAS unsigned char*)a.ws;
    convert_layer_items((const GAS float*)a.in[1], (const GAS float*)a.in[2], (const GAS float*)a.in[9], (const GAS float*)a.in[10], (const GAS float*)a.in[11], (const GAS float*)a.in[12], ws, 0, gw, NGW, lds + wave * 16384, lane, 0, CONV_SPLIT);
    { const GAS float* wsp = (const GAS float*)a.in[6]; GAS bf16_t* o = (GAS bf16_t*)(ws + WS_WSP);
      for (int i = blockIdx.x * 512 + tid; i < NL * 4 * 128 * 128 / 2; i += G * 512) { const int e = 2 * i, jj = e & 127, ii = (e >> 7) & 127;
          const float w0 = jj <= ii ? wsp[e] : 0.f, w1 = (jj + 1) <= ii ? wsp[e + 1] : 0.f; ((GAS unsigned*)o)[i] = cvt_pk_bf16(w0, w1); } }
    { const GAS float* x = (const GAS float*)a.in[0]; GAS bf16_t* xb = (GAS bf16_t*)(ws + WS_XB); GAS float* ssq = (GAS float*)(ws + WS_SSQ);
      for (int row0 = gw; row0 < M; row0 += 4 * NGW) {
          f32x4 v[4][4]; float s[4];
#pragma unroll
          for (int r = 0; r < 4; ++r) { const int row = row0 + r * NGW; if (row < M) { const GAS f32x4* xr = (const GAS f32x4*)(x + (size_t)row * D);
#pragma unroll
              for (int j = 0; j < 4; ++j) v[r][j] = xr[64 * j + lane]; } }
#pragma unroll
          for (int r = 0; r < 4; ++r) { s[r] = 0.f;
#pragma unroll
              for (int j = 0; j < 4; ++j) s[r] += (v[r][j][0] * v[r][j][0] + v[r][j][1] * v[r][j][1]) + (v[r][j][2] * v[r][j][2] + v[r][j][3] * v[r][j][3]); }
          wave_sum2(s[0], s[1]); wave_sum2(s[2], s[3]);
#pragma unroll
          for (int r = 0; r < 4; ++r) { const int row = row0 + r * NGW; if (row < M) { GAS u32x2* o8 = (GAS u32x2*)(xb + (size_t)row * D);
#pragma unroll
              for (int j = 0; j < 4; ++j) o8[64 * j + lane] = pack4(v[r][j]);
              if (lane < 16) ssq[(size_t)lane * M + row] = (lane == 0) ? s[r] : 0.f; } }
      } }
}
__device__ __forceinline__ void final_norm(GAS float* out, const GAS bf16_t* xb, const GAS float* ssq, const GAS float* gfp, int tid) {
    const int lane = tid & 63, wave = tid >> 6, gw = blockIdx.x * 8 + wave, NGW = gridDim.x * 8;
    f32x4 gf[4];
#pragma unroll
    for (int j = 0; j < 2; ++j) { gf[2 * j] = *(const GAS f32x4*)(gfp + 8 * (64 * j + lane)); gf[2 * j + 1] = *(const GAS f32x4*)(gfp + 8 * (64 * j + lane) + 4); }
    for (int row0 = gw; row0 < M; row0 += 4 * NGW) {
        float s[4]; u32x4 w[4][2];
#pragma unroll
        for (int r = 0; r < 4; ++r) { const int row = row0 + r * NGW; s[r] = 0.f; if (row < M) { s[r] = (lane < 16) ? ssq[(size_t)lane * M + row] : 0.f;
            const GAS u32x4* xr = (const GAS u32x4*)(xb + (size_t)row * D); w[r][0] = xr[lane]; w[r][1] = xr[64 + lane]; } }
        wave_sum2(s[0], s[1]); wave_sum2(s[2], s[3]);
#pragma unroll
        for (int r = 0; r < 4; ++r) { const int row = row0 + r * NGW; if (row < M) { const float rs = rsqrtf(s[r] * (1.0f / D) + EPS); GAS f32x4* orow = (GAS f32x4*)(out + (size_t)row * D);
#pragma unroll
            for (int j = 0; j < 2; ++j) { orow[2 * (64 * j + lane)] = unpack4((u32x2){w[r][j].x, w[r][j].y}) * rs * gf[2 * j]; orow[2 * (64 * j + lane) + 1] = unpack4((u32x2){w[r][j].z, w[r][j].w}) * rs * gf[2 * j + 1]; } } }
    }
}


constexpr int MISC_OFF = 139264;
constexpr int RS = 144;
constexpr int VS = 528;
constexpr size_t WS_TOT = 263 * MiB;

constexpr int WSCR_OFF = 118784, WSCR_STRIDE = 144, WSCR_BYTES = 16 * WSCR_STRIDE;
__device__ __forceinline__ void store_tile16x64(LAS unsigned char* wscr, const u32x2 (&pk)[4], GAS bf16_t* dst  , int lane) {
    const int g4 = lane >> 4, i16 = lane & 15;
#pragma unroll
    for (int et = 0; et < 4; ++et) *(LAS u32x2*)(wscr + i16 * WSCR_STRIDE + et * 32 + g4 * 8) = pk[et];
    asm volatile("s_waitcnt lgkmcnt(0)" ::: "memory");
    u32x4 v[2];
#pragma unroll
    for (int hh = 0; hh < 2; ++hh) v[hh] = *(const LAS u32x4*)(wscr + ((lane >> 3) + 8 * hh) * WSCR_STRIDE + (lane & 7) * 16);
    asm volatile("s_waitcnt lgkmcnt(0)" ::: "memory");
#pragma unroll
    for (int hh = 0; hh < 2; ++hh) *(GAS u32x4*)(dst + (size_t)((lane >> 3) + 8 * hh) * D + (lane & 7) * 8) = v[hh];
}
__device__ __forceinline__ void store_tile16x32(LAS unsigned char* wscr, const u32x2 (&pk)[2], GAS bf16_t* dst, int lane) {
    const int g4 = lane >> 4, i16 = lane & 15;
#pragma unroll
    for (int cc = 0; cc < 2; ++cc) *(LAS u32x2*)(wscr + i16 * WSCR_STRIDE + cc * 32 + g4 * 8) = pk[cc];
    asm volatile("s_waitcnt lgkmcnt(0)" ::: "memory");
    const u32x4 v = *(const LAS u32x4*)(wscr + (lane >> 2) * WSCR_STRIDE + (lane & 3) * 16);
    asm volatile("s_waitcnt lgkmcnt(0)" ::: "memory");
    *(GAS u32x4*)(dst + (size_t)(lane >> 2) * D + (lane & 3) * 8) = v;
}

__device__ __forceinline__ void attn_job(LAS unsigned char* lds, const GAS bf16_t* proj, GAS bf16_t* mixed, const GAS float* sinks, int job, int tid) {
    const int kvh = job & 1, n = (job >> 1) & 31, b = job >> 6;
    const int lane = tid & 63, wid = tid >> 6, g4 = lane >> 4, i16 = lane & 15;
    LAS unsigned char* Kl = lds; LAS unsigned char* Vl = lds + 256 * RS;
    u32x4 kr[4], vr[4];
#pragma unroll
    for (int i = 0; i < 4; ++i) { const int c = tid + 512 * i, row = c >> 3, ch = c & 7;
        kr[i] = (u32x4){0u, 0u, 0u, 0u}; vr[i] = kr[i];
        if (n > 0 || row >= 128) { const GAS bf16_t* p = proj + (size_t)(b * T + n * 128 - 128 + row) * NPROJ; kr[i] = *(const GAS u32x4*)(p + C_KA + kvh * 64 + ch * 8); vr[i] = *(const GAS u32x4*)(p + C_VA + kvh * 64 + ch * 8); } }
    bf16x8 qf[3][2]; float sk[3];
#pragma unroll
    for (int qt = 0; qt < 3; ++qt) { const int t = wid * 3 + qt, g = t >> 3, aa = t & 7, h = kvh * 3 + g; sk[qt] = sinks[h];
        const GAS bf16_t* qp = proj + ((size_t)b * T + n * 128 + 16 * aa + i16) * NPROJ + C_QA + h * 64 + 8 * g4;
        qf[qt][0] = *(const GAS bf16x8*)qp; qf[qt][1] = *(const GAS bf16x8*)(qp + 32); }
#pragma unroll
    for (int i = 0; i < 4; ++i) { const int c = tid + 512 * i, row = c >> 3, ch = c & 7;
        *(LAS u32x4*)(Kl + row * RS + ch * 16) = kr[i]; *(LAS u32x4*)(Vl + row * RS + ch * 16) = vr[i]; }
    lds_barrier();
#pragma unroll 1
    for (int qt = 0; qt < 3; ++qt) {
        const int t = wid * 3 + qt, g = t >> 3, aa = t & 7, h = kvh * 3 + g;
        const float slope = (h == 0) ? 0.25f : (h == 1) ? 0.0625f : (h == 2) ? 0.015625f : (h == 3) ? 0.00390625f : (h == 4) ? 0.5f : 0.125f;
        const float sink = qt == 0 ? sk[0] : (qt == 1 ? sk[1] : sk[2]);
        const int iq = 16 * aa + i16; const size_t tok = (size_t)b * T + n * 128 + iq;
        const bf16x8 q0 = qt == 0 ? qf[0][0] : (qt == 1 ? qf[1][0] : qf[2][0]), q1 = qt == 0 ? qf[0][1] : (qt == 1 ? qf[1][1] : qf[2][1]);
        const int kb0 = aa >> 1;
        f32x4 s[10];
#pragma unroll
        for (int kt = 0; kt < 10; ++kt) { const LAS unsigned char* kp = Kl + ((kb0 * 2 + kt) * 16 + i16) * RS + g4 * 16;
            const bf16x8 k0 = *(const LAS bf16x8*)kp, k1 = *(const LAS bf16x8*)(kp + 64);
            f32x4 z = (f32x4){0.f, 0.f, 0.f, 0.f}; z = mfma16(k0, q0, z); z = mfma16(k1, q1, z); s[kt] = z; }
        float mx = sink;
#pragma unroll
        for (int kt = 0; kt < 10; ++kt)
#pragma unroll
            for (int r = 0; r < 4; ++r) { const int kj = (kb0 * 2 + kt) * 16 + 4 * g4 + r, dist = 128 + iq - kj;
                const bool ok = dist >= 0 && dist < 128 && (n > 0 || kj >= 128);
                const float v = ok ? s[kt][r] - slope * (float)dist : -1e30f; s[kt][r] = v; mx = fmaxf(mx, v); }
        mx = fmaxf(mx, __shfl_xor(mx, 16)); mx = fmaxf(mx, __shfl_xor(mx, 32));
        float sum = 0.f;
#pragma unroll
        for (int kt = 0; kt < 10; ++kt)
#pragma unroll
            for (int r = 0; r < 4; ++r) { const float p = __expf(s[kt][r] - mx); s[kt][r] = p; sum += p; }
        sum += __shfl_xor(sum, 16); sum += __shfl_xor(sum, 32);
        const float inv = 1.0f / (sum + __expf(sink - mx));
        f32x4 o[4];
#pragma unroll
        for (int et = 0; et < 4; ++et) o[et] = (f32x4){0.f, 0.f, 0.f, 0.f};
#pragma unroll
        for (int kb = 0; kb < 5; ++kb) { const bf16x8 pb = pack8(s[2 * kb], s[2 * kb + 1]);
#pragma unroll
            for (int et = 0; et < 4; ++et) { const LAS unsigned char* vp = Vl + ((kb0 + kb) * 32 + 4 * g4 + (i16 >> 2)) * RS + (et * 16 + 4 * (i16 & 3)) * 2;
                o[et] = mfma16(mk8(tr_read(vp), tr_read(vp + 16 * RS)), pb, o[et]); } }
        u32x2 pk[4];
#pragma unroll
        for (int et = 0; et < 4; ++et) pk[et] = pack4(o[et] * inv);
        store_tile16x64(lds + WSCR_OFF + wid * WSCR_BYTES, pk, mixed + ((size_t)b * T + n * 128 + 16 * aa) * D + MIX_ATT + h * 64, lane);
    }
}

__device__ __forceinline__ void gmlp_job(LAS unsigned char* lds, const GAS bf16_t* proj, GAS bf16_t* mixed, const GAS bf16_t* wsb, const GAS float* bsp, const GAS float* lng, const GAS float* lnb, int job, int tid) {
    const int n = job & 31, b = job >> 5;
    const int lane = tid & 63, wid = tid >> 6, g4 = lane >> 4, i16 = lane & 15;
    const size_t tok0 = (size_t)b * T + n * 128;
    const int ct0 = 2 * wid, grp = wid >> 1;
    const GAS bf16_t* wg = wsb + (size_t)grp * 128 * 128 + (size_t)i16 * 128 + 8 * g4;
    bf16x8 wf[4][8]; u32x2 ur[8][2]; float bsv[8];
    { const f32x4 gg = *(const GAS f32x4*)(lng + 4 * lane), bb = *(const GAS f32x4*)(lnb + 4 * lane);
      u32x2 xr[16];
#pragma unroll
      for (int rr = 0; rr < 16; ++rr) xr[rr] = *(const GAS u32x2*)(proj + (tok0 + 16 * wid + rr) * NPROJ + C_V + 4 * lane);
#pragma unroll
      for (int kb = 0; kb < 4; ++kb)
#pragma unroll
          for (int aa = 2 * kb; aa < 8; ++aa) wf[kb][aa] = *(const GAS bf16x8*)(wg + (size_t)(16 * aa) * 128 + 32 * kb);
#pragma unroll
      for (int aa = 0; aa < 8; ++aa) { bsv[aa] = bsp[grp * 128 + 16 * aa + i16];
#pragma unroll
          for (int cc = 0; cc < 2; ++cc) ur[aa][cc] = *(const GAS u32x2*)(proj + (tok0 + 16 * aa + i16) * NPROJ + C_U + (ct0 + cc) * 16 + 4 * g4); }
#pragma unroll
      for (int rr = 0; rr < 16; ++rr) { const int row = 16 * wid + rr;
          const f32x4 x = unpack4(xr[rr]);
          float s1 = (x[0] + x[1]) + (x[2] + x[3]), s2 = (x[0] * x[0] + x[1] * x[1]) + (x[2] * x[2] + x[3] * x[3]);
          wave_sum2(s1, s2);
          const float mu = s1 * (1.0f / 256.0f);
          const f32x4 d = x - mu;
          const float var = fmaxf(s2 * (1.0f / 256.0f) - mu * mu, 0.f);
          const float rs = rsqrtf(var + EPS);
          *(LAS u32x2*)(lds + row * VS + lane * 8) = pack4(d * rs * gg + bb); } }
    lds_barrier();
    f32x4 acc[8][2];
#pragma unroll
    for (int aa = 0; aa < 8; ++aa) { acc[aa][0] = (f32x4){0.f, 0.f, 0.f, 0.f}; acc[aa][1] = acc[aa][0]; }
#pragma unroll
    for (int kb = 0; kb < 4; ++kb) {
        bf16x8 af[2];
#pragma unroll
        for (int cc = 0; cc < 2; ++cc) { const LAS unsigned char* vp = lds + (32 * kb + 8 * g4 + (i16 >> 2)) * VS + ((ct0 + cc) * 16 + 4 * (i16 & 3)) * 2; af[cc] = mk8(tr_read(vp), tr_read(vp + 4 * VS)); }
#pragma unroll
        for (int aa = 2 * kb; aa < 8; ++aa)
#pragma unroll
            for (int cc = 0; cc < 2; ++cc) acc[aa][cc] = mfma16(af[cc], wf[kb][aa], acc[aa][cc]);
    }
#pragma unroll
    for (int aa = 0; aa < 8; ++aa) {
        u32x2 pk[2];
#pragma unroll
        for (int cc = 0; cc < 2; ++cc) pk[cc] = pack4(unpack4(ur[aa][cc]) * (acc[aa][cc] + bsv[aa]));
        store_tile16x32(lds + WSCR_OFF + wid * WSCR_BYTES, pk, mixed + (tok0 + 16 * aa) * D + MIX_MLP + ct0 * 16, lane);
    }
}

__device__ __forceinline__ void kvoct_job(LAS unsigned char* lds, const GAS bf16_t* proj, GAS float* Pb, GAS float* Tot, int job, int tid) {
    const int o = job & 3, h = (job >> 2) % 6, b = job / 24;
    const int lane = tid & 63, wid = tid >> 6, g4 = lane >> 4, i16 = lane & 15;
    const float lg2 = log2f(1.0f - exp2f(-5.0f - (float)h)), cd = exp2f(lg2 * 128.0f);
    const int et = wid >> 1, dt0 = (wid & 1) * 2;
    const int row0 = tid >> 3, ch = tid & 7;
    const float tl0 = exp2f(lg2 * (float)(127 - row0)), tl1 = exp2f(lg2 * (float)(63 - row0));
    const GAS bf16_t* src = proj + ((size_t)b * T + (size_t)(8 * o) * 128 + row0) * NPROJ + h * 64 + ch * 8;
    u32x4 kk[4][2], vv[4][2];
#pragma unroll
    for (int s = 0; s < 4; ++s) { const GAS bf16_t* s2 = src + (size_t)s * 128 * NPROJ;
        kk[s][0] = *(const GAS u32x4*)(s2 + C_KR); vv[s][0] = *(const GAS u32x4*)(s2 + C_VR); kk[s][1] = *(const GAS u32x4*)(s2 + (size_t)64 * NPROJ + C_KR); vv[s][1] = *(const GAS u32x4*)(s2 + (size_t)64 * NPROJ + C_VR); }
    f32x4 P[2]; P[0] = (f32x4){0.f, 0.f, 0.f, 0.f}; P[1] = P[0];
    GAS float* po = Pb + ((size_t)((b * 6 + h) * 32 + 8 * o)) * 4096 + (et * 16 + i16) * 64 + dt0 * 16 + 4 * g4;
#pragma unroll
    for (int c = 0; c < 8; ++c) {
        const int s = c & 3;
        LAS unsigned char* Kl = lds + (c & 1) * (256 * RS); LAS unsigned char* Vl = Kl + 128 * RS;
        *(LAS bf16x8*)(Kl + row0 * RS + ch * 16) = pack8(unpack4((u32x2){kk[s][0].x, kk[s][0].y}) * tl0, unpack4((u32x2){kk[s][0].z, kk[s][0].w}) * tl0);
        *(LAS bf16x8*)(Kl + (row0 + 64) * RS + ch * 16) = pack8(unpack4((u32x2){kk[s][1].x, kk[s][1].y}) * tl1, unpack4((u32x2){kk[s][1].z, kk[s][1].w}) * tl1);
        *(LAS u32x4*)(Vl + row0 * RS + ch * 16) = vv[s][0]; *(LAS u32x4*)(Vl + (row0 + 64) * RS + ch * 16) = vv[s][1];
        if (c + 4 < 8) { const GAS bf16_t* s2 = src + (size_t)(c + 4) * 128 * NPROJ;
            kk[s][0] = *(const GAS u32x4*)(s2 + C_KR); vv[s][0] = *(const GAS u32x4*)(s2 + C_VR); kk[s][1] = *(const GAS u32x4*)(s2 + (size_t)64 * NPROJ + C_KR); vv[s][1] = *(const GAS u32x4*)(s2 + (size_t)64 * NPROJ + C_VR); }
        lds_barrier();
        *(GAS f32x4*)(po + (size_t)c * 4096) = P[0]; *(GAS f32x4*)(po + (size_t)c * 4096 + 16) = P[1];
        f32x4 acc[2]; acc[0] = (f32x4){0.f, 0.f, 0.f, 0.f}; acc[1] = acc[0];
#pragma unroll
        for (int ks = 0; ks < 4; ++ks) {
            const int rowb = 32 * ks + 8 * g4 + (i16 >> 2);
            const LAS unsigned char* vp = Vl + rowb * RS + (et * 16 + 4 * (i16 & 3)) * 2;
            const bf16x8 vf = mk8(tr_read(vp), tr_read(vp + 4 * RS));
#pragma unroll
            for (int dd = 0; dd < 2; ++dd) { const LAS unsigned char* kp = Kl + rowb * RS + ((dt0 + dd) * 16 + 4 * (i16 & 3)) * 2;
                acc[dd] = mfma16(mk8(tr_read(kp), tr_read(kp + 4 * RS)), vf, acc[dd]); }
        }
        P[0] = P[0] * cd + acc[0]; P[1] = P[1] * cd + acc[1];
    }
    GAS float* to = Tot + ((size_t)((b * 6 + h) * 4 + o)) * 4096 + (et * 16 + i16) * 64 + dt0 * 16 + 4 * g4;
    *(GAS f32x4*)to = P[0]; *(GAS f32x4*)(to + 16) = P[1];
}

struct RetRegs { u32x4 k0, k1, v0, v1; f32x4 s0, s1, t0[3], t1[3]; bf16x8 q0, q1; u32x2 gtr[4]; f32x4 rg[4]; };
constexpr int RET_BUF = 320 * RS;
__device__ __forceinline__ void ret_load(RetRegs& R, const GAS bf16_t* proj, const GAS float* Pb, const GAS float* Tot, const GAS float* retg, int job, int tid) {
    const int n = job & 31, h = (job >> 5) % 6, b = job / 192;
    const int lane = tid & 63, wid = tid >> 6, g4 = lane >> 4, i16 = lane & 15;
    const size_t tok0 = (size_t)b * T + n * 128, tok = tok0 + 16 * wid + i16;
    const int row0 = tid >> 3, ch = tid & 7;
    const GAS bf16_t* src = proj + (tok0 + row0) * NPROJ + h * 64 + ch * 8;
    R.k0 = *(const GAS u32x4*)(src + C_KR); R.v0 = *(const GAS u32x4*)(src + C_VR); R.k1 = *(const GAS u32x4*)(src + (size_t)64 * NPROJ + C_KR); R.v1 = *(const GAS u32x4*)(src + (size_t)64 * NPROJ + C_VR);
    const int oc = n >> 3;
    const GAS float* pp = Pb + ((size_t)((b * 6 + h) * 32 + n)) * 4096 + tid * 8;
    R.s0 = *(const GAS f32x4*)pp; R.s1 = *(const GAS f32x4*)(pp + 4);
#pragma unroll
    for (int oo = 0; oo < 3; ++oo) { const int os = oo < oc ? oo : 0; const GAS float* tp = Tot + ((size_t)((b * 6 + h) * 4 + os)) * 4096 + tid * 8;
        R.t0[oo] = *(const GAS f32x4*)tp; R.t1[oo] = *(const GAS f32x4*)(tp + 4); }
    const GAS bf16_t* qp = proj + tok * NPROJ + C_QR + h * 64 + 8 * g4;
    R.q0 = *(const GAS bf16x8*)qp; R.q1 = *(const GAS bf16x8*)(qp + 32);
#pragma unroll
    for (int et = 0; et < 4; ++et) { const int c = h * 64 + et * 16 + 4 * g4; R.gtr[et] = *(const GAS u32x2*)(proj + tok * NPROJ + C_GR + c); R.rg[et] = *(const GAS f32x4*)(retg + c); }
}
__device__ __forceinline__ void ret_stage(const RetRegs& R, LAS unsigned char* buf, int job, int tid) {
    const int n = job & 31, h = (job >> 5) % 6, oc = n >> 3;
    const float lg2 = log2f(1.0f - exp2f(-5.0f - (float)h));
    LAS unsigned char* Kl = buf; LAS unsigned char* Vl = buf + 128 * RS; LAS unsigned char* Sl = buf + 256 * RS;
    const int row0 = tid >> 3, ch = tid & 7;
    *(LAS u32x4*)(Kl + row0 * RS + ch * 16) = R.k0; *(LAS u32x4*)(Kl + (row0 + 64) * RS + ch * 16) = R.k1;
    *(LAS u32x4*)(Vl + row0 * RS + ch * 16) = R.v0; *(LAS u32x4*)(Vl + (row0 + 64) * RS + ch * 16) = R.v1;
    f32x4 s0 = R.s0, s1 = R.s1;
#pragma unroll
    for (int oo = 0; oo < 3; ++oo) { const float tf = oo < oc ? exp2f(lg2 * 128.0f * (float)(n - 8 * (oo + 1))) : 0.f; s0 = s0 + R.t0[oo] * tf; s1 = s1 + R.t1[oo] * tf; }
    *(LAS bf16x8*)(Sl + (tid >> 3) * RS + (tid & 7) * 16) = pack8(s0, s1);
}
__device__ __forceinline__ void ret_compute(const RetRegs& R, const LAS unsigned char* buf, LAS unsigned char* wscr, GAS bf16_t* mixed, int job, int tid) {
    const int n = job & 31, h = (job >> 5) % 6, b = job / 192;
    const int lane = tid & 63, wid = tid >> 6, g4 = lane >> 4, i16 = lane & 15;
    const float lg2 = log2f(1.0f - exp2f(-5.0f - (float)h));
    const LAS unsigned char* Kl = buf; const LAS unsigned char* Vl = buf + 128 * RS; const LAS unsigned char* Sl = buf + 256 * RS;
    const int aa = wid, iq = 16 * aa + i16; const size_t tok = (size_t)b * T + n * 128 + iq;
    const bf16x8 q0 = R.q0, q1 = R.q1;
    f32x4 o[4];
#pragma unroll
    for (int et = 0; et < 4; ++et) o[et] = (f32x4){0.f, 0.f, 0.f, 0.f};
    f32x4 s[4][2];
#pragma unroll
    for (int kb = 0; kb < 4; ++kb)
#pragma unroll
        for (int tt = 0; tt < 2; ++tt) { const LAS unsigned char* kp = Kl + ((2 * kb + tt) * 16 + i16) * RS + g4 * 16;
            const bf16x8 ka = *(const LAS bf16x8*)kp, kb2 = *(const LAS bf16x8*)(kp + 64);
            f32x4 z = (f32x4){0.f, 0.f, 0.f, 0.f}; z = mfma16(ka, q0, z); z = mfma16(kb2, q1, z); s[kb][tt] = z; }
#pragma unroll
    for (int kb = 0; kb < 4; ++kb)
#pragma unroll
        for (int tt = 0; tt < 2; ++tt)
#pragma unroll
            for (int r = 0; r < 4; ++r) { const int dl = iq - ((2 * kb + tt) * 16 + 4 * g4 + r); s[kb][tt][r] = dl >= 0 ? s[kb][tt][r] * __builtin_amdgcn_exp2f(lg2 * (float)dl) : 0.f; }
#pragma unroll
    for (int kb = 0; kb < 4; ++kb) {
        const bf16x8 pb = pack8(s[kb][0], s[kb][1]);
#pragma unroll
        for (int et = 0; et < 4; ++et) { const LAS unsigned char* vp = Vl + (kb * 32 + 4 * g4 + (i16 >> 2)) * RS + (et * 16 + 4 * (i16 & 3)) * 2;
            o[et] = mfma16(mk8(tr_read(vp), tr_read(vp + 16 * RS)), pb, o[et]); }
    }
    { const float hd = exp2f(lg2 * (float)(iq + 1));
#pragma unroll
      for (int et = 0; et < 4; ++et) { const LAS unsigned char* sp = Sl + (et * 16 + i16) * RS + g4 * 16;
          f32x4 z = (f32x4){0.f, 0.f, 0.f, 0.f}; z = mfma16(*(const LAS bf16x8*)sp, q0, z); z = mfma16(*(const LAS bf16x8*)(sp + 64), q1, z);
          o[et] = o[et] + z * hd; } }
    float ss = 0.f;
#pragma unroll
    for (int et = 0; et < 4; ++et) ss += (o[et][0] * o[et][0] + o[et][1] * o[et][1]) + (o[et][2] * o[et][2] + o[et][3] * o[et][3]);
    ss += __shfl_xor(ss, 16); ss += __shfl_xor(ss, 32);
    const float rinv = rsqrtf(ss * (1.0f / 64.0f) + EPS);
    u32x2 pk[4];
#pragma unroll
    for (int et = 0; et < 4; ++et) {
        const f32x4 gt = unpack4(R.gtr[et]);
        f32x4 y;
#pragma unroll
        for (int r = 0; r < 4; ++r) y[r] = o[et][r] * rinv * R.rg[et][r] * gt[r] * __builtin_amdgcn_rcpf(1.0f + __expf(-gt[r]));
        pk[et] = pack4(y); }
    store_tile16x64(wscr, pk, mixed + ((size_t)b * T + n * 128 + 16 * aa) * D + MIX_RET + h * 64, lane);
}

#define RLX_AGENT __ATOMIC_RELAXED, __HIP_MEMORY_SCOPE_AGENT
#define XB_TMO      128
#define XB_XCNT(j)  (256  + 64 * (j))
#define XB_XSUB(j)  (1280 + 64 * (j))
#define XB_XGEN(j)  (2304 + 64 * (j))
#define XB_TOP      3328
#define XB_TOPGEN   3392
#define XCD_BAR_WORDS 3456
#define XB_SPIN_CAP (1u << 18)

__device__ __forceinline__ unsigned xb_ld(unsigned* p)              { return __hip_atomic_load(p, __ATOMIC_RELAXED, __HIP_MEMORY_SCOPE_AGENT); }
__device__ __forceinline__ unsigned xb_add(unsigned* p, unsigned v) { return __hip_atomic_fetch_add(p, v, __ATOMIC_RELAXED, __HIP_MEMORY_SCOPE_AGENT); }
__device__ __forceinline__ unsigned xb_xcc_id() { return (unsigned)__builtin_amdgcn_s_getreg((3 << 11) | 20) & 0xFu; }
#define XB_SPIN(cond, bar) do { unsigned _sp = 0; while (cond) { __builtin_amdgcn_s_sleep(1); \
    if ((++_sp & 255u) == 0u) { if (xb_ld(&(bar)[XB_TMO])) break; if (_sp > XB_SPIN_CAP) { atomicAdd(&(bar)[XB_TMO], 1u); break; } } } } while (0)

struct XcdBarrier {
    unsigned* bar; unsigned x;
    volatile LAS unsigned* st;
};

__device__ __forceinline__ XcdBarrier xcd_barrier_post(unsigned* bar, volatile LAS unsigned* st) {
    XcdBarrier b; b.bar = bar; b.x = xb_xcc_id(); b.st = st;
    if (threadIdx.x == 0) (void)xb_add(&bar[XB_XCNT(b.x)], 1u);
    return b;
}
__device__ __forceinline__ void xcd_barrier_complete(unsigned* bar, unsigned x, unsigned& nloc, unsigned& nx) {
    const unsigned G = gridDim.x * gridDim.y * gridDim.z;
    unsigned sum, cnt, mine, sp = 0u;
    for (;;) {
        sum = 0u; cnt = 0u; mine = 0u;
#pragma unroll
        for (unsigned j = 0; j < 16; ++j) { const unsigned c = xb_ld(&bar[XB_XCNT(j)]); sum += c; cnt += (c > 0u) ? 1u : 0u; mine = (j == x) ? c : mine; }
        if (sum == G) break;
        __builtin_amdgcn_s_sleep(1);
        if ((++sp & 255u) == 0u) { if (xb_ld(&bar[XB_TMO])) break; if (sp > XB_SPIN_CAP) { atomicAdd(&bar[XB_TMO], 1u); break; } }
    }
    nloc = mine > 0u ? mine : 1u; nx = cnt > 0u ? cnt : 1u;
}

__device__ __forceinline__ void xcd_barrier(const XcdBarrier& b) {
    asm volatile("s_waitcnt vmcnt(0)" ::: "memory");
    __syncthreads();
    if (threadIdx.x == 0) {
        unsigned* bar = b.bar;
        __builtin_amdgcn_s_waitcnt(0);
        unsigned nloc = b.st[0], nx = b.st[1];
        if (nloc == 0u) { xcd_barrier_complete(bar, b.x, nloc, nx); b.st[0] = nloc; b.st[1] = nx; }
        const unsigned old = xb_add(&bar[XB_XSUB(b.x)], 1u);
        const unsigned gen = old / nloc;
        if (old + 1u == (gen + 1u) * nloc) {
            __builtin_amdgcn_fence(__ATOMIC_RELEASE, "agent");
            asm volatile("s_waitcnt vmcnt(0)" ::: "memory");
            const unsigned og = xb_add(&bar[XB_TOP], 1u);
            const unsigned tg = og / nx;
            if (og + 1u == (tg + 1u) * nx) xb_add(&bar[XB_TOPGEN], 1u);
            else XB_SPIN(xb_ld(&bar[XB_TOPGEN]) == tg, bar);
            __builtin_amdgcn_fence(__ATOMIC_ACQUIRE, "agent");
            xb_add(&bar[XB_XGEN(b.x)], 1u);
            asm volatile("s_waitcnt vmcnt(0)" ::: "memory");
        } else {
            XB_SPIN(xb_ld(&bar[XB_TOPGEN]) == gen, bar);
            __builtin_amdgcn_fence(__ATOMIC_ACQUIRE, "agent");
            asm volatile("s_waitcnt vmcnt(0)" ::: "memory");
        }
    }
    __syncthreads();
}

constexpr size_t WS_BAR = 65536;
__device__ __forceinline__ GAS unsigned char* launder_ptr(unsigned char* p) {
    unsigned lo = (unsigned)(unsigned long long)p, hi = (unsigned)((unsigned long long)p >> 32); asm volatile("" : "+v"(lo), "+v"(hi));
    lo = __builtin_amdgcn_readfirstlane(lo); hi = __builtin_amdgcn_readfirstlane(hi); return (GAS unsigned char*)(((unsigned long long)hi << 32) | lo);
}
__device__ __forceinline__ int retjob(int bb, int idx, int nhalf, int k) { const int q = idx * 3 + k; return bb * 192 + (q >> 4) * 32 + nhalf + (q & 15); }
__device__ __forceinline__ void kv_wait(unsigned* kvc, int tid) {
    if (tid == 0) { unsigned sp = 0; while (__hip_atomic_load(kvc, __ATOMIC_RELAXED, __HIP_MEMORY_SCOPE_AGENT) < 96u) { __builtin_amdgcn_s_sleep(2); if (++sp > (1u << 22)) break; }
        __builtin_amdgcn_fence(__ATOMIC_ACQUIRE, "agent"); asm volatile("s_waitcnt vmcnt(0)" ::: "memory"); }
    lds_barrier();
}
#define PH(k, ...) do { int tid = threadIdx.x; asm volatile("" : "+v"(tid)); int bid_ = blockIdx.x; asm volatile("" : "+v"(bid_)); const int bid = __builtin_amdgcn_readfirstlane(bid_); (void)bid; \
    GAS unsigned char* ws = launder_ptr(a.ws); __VA_ARGS__ } while (0)
#define GSYNC() xcd_barrier(bar)
#define PTAB(i) ((const GAS float*)(((const GAS unsigned long long*)ws)[i]))
__global__ void __launch_bounds__(512, 2) fwd_mega(Args a) {
    extern __shared__ __attribute__((aligned(16))) unsigned char lds_raw[];
    LAS unsigned char* lds = (LAS unsigned char*)lds_raw;
    cg::grid_group grid = cg::this_grid();
    if (a.ws == nullptr) grid.sync();
    { volatile LAS unsigned* misc = (volatile LAS unsigned*)(lds + MISC_OFF); if (threadIdx.x < 32) misc[threadIdx.x] = 0u; __syncthreads(); }
    const XcdBarrier bar = xcd_barrier_post((unsigned*)(a.ws + WS_BAR), (volatile LAS unsigned*)(lds + MISC_OFF + 32));
    PH(6, { prologue(a, lds, tid); if (blockIdx.x == 0 && tid == 0) { _Pragma("unroll") for (int i_ = 0; i_ < 14; ++i_) ((GAS unsigned long long*)ws)[i_] = (unsigned long long)a.in[i_]; } });
    GSYNC();
#pragma unroll 1
    for (int l = 0; l < NL; ++l) {
        PH(0, {
            pg8::Gemm g{(const bf16_t*)(ws + WS_XB), (const bf16_t*)(ws + WS_W1) + (size_t)l * NPROJ * D, M, NPROJ, D}; pg8::StaticOrder S; S.init(M, NPROJ, (int)gridDim.x, bid);
            LAS float* rtab = (LAS float*)(lds + RTAB_OFF);
            build_rtab(rtab, S, (const GAS float*)(ws + WS_SSQ), tid);
            EpiProj E{(GAS bf16_t*)(ws + WS_PROJ), rtab};
            pg8::gemm_phase<EpiProj, pg8::StaticOrder, true, true>(lds, g, S, E);
            if (l == 0 && bid >= 192)
                convert_layer_items(PTAB(1), PTAB(2), PTAB(9), PTAB(10), PTAB(11), PTAB(12), ws, 0, (bid - 192) * 8 + (tid >> 6), ((int)gridDim.x - 192) * 8, lds + (tid >> 6) * 16384, tid & 63, CONV_SPLIT, CONV_IL); });
        GSYNC();
        PH(1, {
            const GAS bf16_t* PROJ = (const GAS bf16_t*)(ws + WS_PROJ); GAS bf16_t* MIX = (GAS bf16_t*)(ws + WS_MIX);
            unsigned* kvcnt = (unsigned*)(ws + WS_BAR) + 4096 + 64 * l;
            const int c = bid;
            if (gridDim.x == 256) {
                unsigned* kvc = kvcnt;
                const GAS float* Pb = (const GAS float*)(ws + WS_KV); const GAS float* Tot = (const GAS float*)(ws + WS_TOT); const GAS float* retg = PTAB(3) + l * 384;
                const int xcd = c & 7, idx = c >> 3, bb = xcd >> 1, nhalf = (xcd & 1) * 16;
                const int nj = 3;
                if (c < 96) {
                    kvoct_job(lds, PROJ, (GAS float*)(ws + WS_KV), (GAS float*)(ws + WS_TOT), bb * 24 + (idx % 6) * 4 + (xcd & 1) * 2 + idx / 6, tid);
                    asm volatile("s_waitcnt vmcnt(0)" ::: "memory"); lds_barrier();
                    if (tid == 0) { __builtin_amdgcn_fence(__ATOMIC_RELEASE, "agent"); asm volatile("s_waitcnt vmcnt(0)" ::: "memory"); __hip_atomic_fetch_add(kvc, 1u, __ATOMIC_RELAXED, __HIP_MEMORY_SCOPE_AGENT); }
                } else if (c < 224) gmlp_job(lds, PROJ, MIX, (const GAS bf16_t*)(ws + WS_WSP) + (size_t)l * 4 * 128 * 128, PTAB(7) + l * 512, PTAB(4) + l * 256, PTAB(5) + l * 256, (bb << 5) | (nhalf + idx - 12), tid);
                lds_barrier();
                attn_job(lds, PROJ, MIX, PTAB(8) + l * 6, (bb << 6) | ((nhalf + (idx >> 1)) << 1) | (idx & 1), tid);
                kv_wait(kvc, tid);
                RetRegs cur;
                ret_load(cur, PROJ, Pb, Tot, retg, retjob(bb, idx, nhalf, 0), tid);
                lds_barrier();
                _Pragma("unroll 1") for (int k = 0; k < nj; ++k) {
                    LAS unsigned char* buf = lds + (k & 1) * RET_BUF;
                    ret_stage(cur, buf, retjob(bb, idx, nhalf, k), tid);
                    lds_barrier();
                    RetRegs nxt; ret_load(nxt, PROJ, Pb, Tot, retg, retjob(bb, idx, nhalf, k + 1 < nj ? k + 1 : k), tid);
                    ret_compute(cur, buf, lds + WSCR_OFF + (tid >> 6) * WSCR_BYTES, MIX, retjob(bb, idx, nhalf, k), tid);
                    cur = nxt;
                }
            } });
        GSYNC();
        PH(3, {
            pg8::Gemm g{(const bf16_t*)(ws + WS_MIX), (const bf16_t*)(ws + WS_W2) + (size_t)l * D * D, M, D, D}; pg8::StaticOrder S; S.init(M, D, (int)gridDim.x, bid);
            EpiResid E{(GAS bf16_t*)(ws + WS_XB), (GAS float*)(ws + WS_SSQ)};
            pg8::gemm_phase<EpiResid, pg8::StaticOrder, true, true>(lds, g, S, E); });
        GSYNC();
        PH(4, {
            pg8::Gemm g{(const bf16_t*)(ws + WS_XB), (const bf16_t*)(ws + WS_W3) + (size_t)l * 2 * DFF * D, M, 2 * DFF, D}; pg8::StaticOrder S; S.init(M, 2 * DFF, (int)gridDim.x, bid);
            LAS float* rtab = (LAS float*)(lds + RTAB_OFF);
            build_rtab(rtab, S, (const GAS float*)(ws + WS_SSQ), tid);
            EpiSwiGLU E{(GAS bf16_t*)(ws + WS_PROJ), rtab};
            pg8::gemm_phase<EpiSwiGLU, pg8::StaticOrder, true, true>(lds, g, S, E);
            if (l + 1 < NL && bid >= CONV_FIRST_WG)
                convert_layer_items(PTAB(1), PTAB(2), PTAB(9), PTAB(10), PTAB(11), PTAB(12), ws, l + 1, (bid - CONV_FIRST_WG) * 8 + (tid >> 6), ((int)gridDim.x - CONV_FIRST_WG) * 8, lds + (tid >> 6) * 16384, tid & 63); });
        GSYNC();
        PH(5, {
            pg8::Gemm g{(const bf16_t*)(ws + WS_PROJ), (const bf16_t*)(ws + WS_W4) + (size_t)l * D * DFF, M, D, DFF}; pg8::StaticOrder S; S.init(M, D, (int)gridDim.x, bid);
            EpiResid E{(GAS bf16_t*)(ws + WS_XB), (GAS float*)(ws + WS_SSQ)};
            pg8::gemm_phase<EpiResid, pg8::StaticOrder, true, true>(lds, g, S, E); });
        GSYNC();
    }
    PH(8, { final_norm((GAS float*)a.out, (const GAS bf16_t*)(ws + WS_XB), (const GAS float*)(ws + WS_SSQ), PTAB(13), tid); });
}

extern "C" void kernel_launch(void* const* d_in, const int* in_sizes, int n_in, void* d_out, int out_size, void* d_ws, size_t ws_size, hipStream_t stream) {
    static int grid = 0;
    if (grid == 0) {
        if (n_in != 14 || out_size != M * D || ws_size < WS_END) { fprintf(stderr, "kernel_launch: unexpected shapes (n_in %d, out %d, ws %zu)\n", n_in, out_size, ws_size); grid = -1; return; }
        int dev = 0, cus = 0, per_cu = 0;
        (void)hipGetDevice(&dev); (void)hipDeviceGetAttribute(&cus, hipDeviceAttributeMultiprocessorCount, dev);
        if (hipFuncSetAttribute((const void*)fwd_mega, hipFuncAttributeMaxDynamicSharedMemorySize, LDS_BYTES) != hipSuccess) { fprintf(stderr, "kernel_launch: hipFuncSetAttribute failed\n"); grid = -1; return; }
        (void)hipOccupancyMaxActiveBlocksPerMultiprocessor(&per_cu, (const void*)fwd_mega, 512, LDS_BYTES);
        (void)hipGetLastError();
        if (per_cu < 1) fprintf(stderr, "kernel_launch: occupancy query says %d blocks/CU\n", per_cu);
        grid = cus;
        if (grid != 256) fprintf(stderr, "kernel_launch: %d CUs (built for 256)\n", grid);
    }
    if (grid < 0) return;
    Args a{};
    for (int i = 0; i < 14; ++i) a.in[i] = (const float*)d_in[i];
    a.out = (float*)d_out; a.ws = (unsigned char*)d_ws;
    if (hipMemsetAsync((unsigned char*)d_ws + WS_BAR, 0, 32768, stream) != hipSuccess) { fprintf(stderr, "kernel_launch: memset of barrier words failed\n"); return; }
    void* args[] = {&a};
    hipError_t e = hipLaunchCooperativeKernel((const void*)fwd_mega, dim3(grid), dim3(512), args, LDS_BYTES, stream);
    if (e != hipSuccess) fprintf(stderr, "kernel_launch: cooperative launch failed: %s (grid %d)\n", hipGetErrorString(e), grid);
}
```

```cpp
#include <hip/hip_runtime.h>
#include <hip/hip_cooperative_groups.h>
#include <cstdio>
#include <cstdint>
namespace cg = cooperative_groups;
namespace pg8 {
#define PG8_LAS __attribute__((address_space(3)))
typedef unsigned short bf16_t;
typedef short bf16x8 __attribute__((ext_vector_type(8)));
typedef float f32x4 __attribute__((ext_vector_type(4)));
typedef unsigned u32x4 __attribute__((ext_vector_type(4)));
constexpr int BM = 256, BK = 64, HALF = 128, HTB = HALF * BK * 2  , STAGE_BYTES = 8 * HTB, NXCD = 8, WGM = 8;

__host__ __device__ __forceinline__ int lds_byte(int r, int c) { const int st = (r >> 4) * 2 + (c >> 5), rr = r & 15, cc = c & 31, ob = rr * 64 + cc * 2; return st * 1024 + (ob ^ (((ob >> 9) & 1) << 5)); }
__host__ __device__ __forceinline__ void stage_rc(int b, int& R, int& C) { const int st = b / 1024, sb = b % 1024, swz = sb ^ (((sb >> 9) & 1) << 5); R = (st >> 1) * 16 + swz / 64; C = (st & 1) * 32 + (swz % 64) / 2; }
__host__ __device__ __forceinline__ int perm32(int rho) { const int n = rho >> 4, i = rho & 15; return 8 * (i >> 2) + 4 * n + (i & 3); }

struct Unit { int pm, pn; };
struct Gemm { const bf16_t* A; const bf16_t* Bt; int M, N, K; };

struct StaticOrder {
    int nM, nN, nwg, G, c, wgm;
    __host__ __device__ void init(int M, int N, int G_, int c_, int wgm_ = WGM) { nM = M / BM; nN = N / BM; nwg = nM * nN; G = G_; c = c_; wgm = wgm_; }
    __host__ __device__ bool next(int i, Unit& u) const {
        const long L = (long)i * G + c; if (L >= nwg) return false;
        int wgid = (int)L; { const int q = nwg / NXCD, r = nwg % NXCD, xcd = wgid % NXCD, off = wgid / NXCD; wgid = (xcd < r ? xcd * (q + 1) : r * (q + 1) + (xcd - r) * q) + off; }
        const int nig = wgm * nN, gid = wgid / nig, fm = gid * wgm, gsz = (nM - fm) < wgm ? (nM - fm) : wgm;
        u.pm = fm + ((wgid % nig) % gsz); u.pn = (wgid % nig) / gsz; return true;
    }
    __device__ __forceinline__ void a_ready(const Unit&) const {}
    __device__ __forceinline__ void done(const Unit&) const {}
};
__device__ __forceinline__ unsigned cvt_pk_bf16(float lo, float hi) { unsigned r; asm volatile("v_cvt_pk_bf16_f32 %0, %1, %2" : "=v"(r) : "v"(lo), "v"(hi)); return r; }
typedef float f32x2 __attribute__((ext_vector_type(2)));
__device__ __forceinline__ f32x2 gelu_pk(f32x2 v) {
    const f32x2 av = __builtin_elementwise_abs(v), d = av * 0.2316418882f + 1.0f;
    f32x2 t; t.x = __builtin_amdgcn_rcpf(d.x); t.y = __builtin_amdgcn_rcpf(d.y);
    f32x2 q = t * 0.5307027145f + (-0.7265760135f); q = q * t + 0.7107068705f; q = q * t + (-0.142248368f); q = q * t + 0.127414796f; q = q * t;
    const f32x2 s = (v * v) * (-0.72134752044f);
    f32x2 e; e.x = __builtin_amdgcn_exp2f(s.x); e.y = __builtin_amdgcn_exp2f(s.y);
    const f32x2 m = v * (q * e), r = v - m;
    f32x2 o; o.x = v.x < 0.f ? m.x : r.x; o.y = v.y < 0.f ? m.y : r.y; return o;
}
template <class Epi, class Sched, bool ALIGN_EPI = false, bool SP2 = false>
__device__ __forceinline__ void gemm_phase(PG8_LAS unsigned char* lds, const Gemm g, const Sched& S, const Epi& E) {
    int tid_ = threadIdx.x; asm volatile("" : "+v"(tid_));
    const int tid = tid_, wid = __builtin_amdgcn_readfirstlane(tid >> 6), lane = tid & 63, wr = wid >> 2, wc = wid & 3, fr = lane & 15, fq = lane >> 4;
    const int K = g.K, nt = K / BK;
    unsigned voffA[2], voffB[2];
#pragma unroll
    for (int i = 0; i < 2; ++i) { int R, C; stage_rc(tid * 16 + i * 8192, R, C); const int Rb = Epi::PERM ? ((R & ~31) + perm32(R & 31)) : R;
        voffA[i] = (unsigned)(R * K + C) * 2u; voffB[i] = (unsigned)(Rb * K + C) * 2u; }
    const size_t kstep = (size_t)(BK * 2);
    const size_t hstep = (size_t)HALF * K * 2;
    const size_t tstep = 2 * hstep;
    const unsigned ldsw = (unsigned)wid * 1024u;
    const int aoff = lds_byte(wr * 64 + fr, fq * 8), boff = lds_byte(wc * 32 + fr, fq * 8);
#define PG8_SA(b, h) (((b) * 2 + (h)) * HTB)
#define PG8_SB(b, h) ((4 + (b) * 2 + (h)) * HTB)
#define PG8_STAGE(bufoff, gbase, voff) do { _Pragma("unroll") for (int _i = 0; _i < 2; ++_i) \
        __builtin_amdgcn_global_load_lds((const unsigned*)((const char*)(gbase) + (voff)[_i]), (PG8_LAS unsigned*)(lds + (bufoff) + ldsw + _i * 8192), 16, 0, 0); } while (0)
#define PG8_LDA(dst, b, h) do { _Pragma("unroll") for (int m = 0; m < 4; ++m) _Pragma("unroll") for (int k = 0; k < 2; ++k) dst[m][k] = *(const PG8_LAS bf16x8*)(lds + PG8_SA(b, h) + aoff + m * 2048 + k * 1024); } while (0)
#define PG8_LDB(dst, b, h) do { _Pragma("unroll") for (int n = 0; n < 2; ++n) _Pragma("unroll") for (int k = 0; k < 2; ++k) dst[n][k] = *(const PG8_LAS bf16x8*)(lds + PG8_SB(b, h) + boff + n * 2048 + k * 1024); } while (0)
#define PG8_MMA(ai, bj, At, Bt) do { __builtin_amdgcn_s_setprio(1); _Pragma("unroll") for (int m = 0; m < 4; ++m) _Pragma("unroll") for (int n = 0; n < 2; ++n) _Pragma("unroll") for (int k = 0; k < 2; ++k) \
        acc[ai][bj][m][n] = __builtin_amdgcn_mfma_f32_16x16x32_bf16(Bt[n][k], At[m][k], acc[ai][bj][m][n], 0, 0, 0); __builtin_amdgcn_s_setprio(0); } while (0)
#define PG8_WAIT_V(n) asm volatile("s_waitcnt vmcnt(" #n ")" ::: "memory")
#define PG8_WAIT_L(n) asm volatile("s_waitcnt lgkmcnt(" #n ")" ::: "memory")
#define PG8_BAR __builtin_amdgcn_s_barrier()
#define PG8_SCHED __builtin_amdgcn_sched_barrier(0)
    Unit cur, nxt; int ui = 0;
    if (!S.next(0, cur)) return;
    f32x4 acc[2][2][4][2];
#pragma unroll
    for (int a = 0; a < 2; ++a)
#pragma unroll
        for (int b = 0; b < 2; ++b)
#pragma unroll
            for (int m = 0; m < 4; ++m)
#pragma unroll
                for (int n = 0; n < 2; ++n) acc[a][b][m][n] = (f32x4){0.f, 0.f, 0.f, 0.f};
    bf16x8 At[4][2], B0[2][2], B1[2][2];
    const char* cA = (const char*)g.A + (size_t)cur.pm * tstep; const char* cB = (const char*)g.Bt + (size_t)cur.pn * tstep;
    S.a_ready(cur);
    if constexpr (SP2) {
        PG8_STAGE(PG8_SB(0, 0), cB, voffB); PG8_STAGE(PG8_SB(0, 1), cB + hstep, voffB); PG8_STAGE(PG8_SA(0, 0), cA, voffA); PG8_STAGE(PG8_SA(0, 1), cA + hstep, voffA);
        if (wr == 1) PG8_BAR;
        PG8_WAIT_V(2); PG8_BAR;
        PG8_STAGE(PG8_SB(1, 0), cB + kstep, voffB); PG8_STAGE(PG8_SA(1, 0), cA + kstep, voffA); PG8_STAGE(PG8_SB(1, 1), cB + hstep + kstep, voffB);
        PG8_WAIT_V(6); PG8_BAR;
    } else {
        PG8_STAGE(PG8_SB(0, 0), cB, voffB); PG8_STAGE(PG8_SA(0, 0), cA, voffA); PG8_STAGE(PG8_SB(0, 1), cB + hstep, voffB); PG8_STAGE(PG8_SA(0, 1), cA + hstep, voffA);
        if (wr == 1) PG8_BAR;
        PG8_WAIT_V(4); PG8_BAR;
        PG8_STAGE(PG8_SB(1, 0), cB + kstep, voffB); PG8_STAGE(PG8_SA(1, 0), cA + kstep, voffA); PG8_STAGE(PG8_SB(1, 1), cB + hstep + kstep, voffB);
        PG8_WAIT_V(6); PG8_BAR;
    }
    for (;;) {
        const bool has_next = S.next(ui + 1, nxt);
        const char* nA = has_next ? (const char*)g.A + (size_t)nxt.pm * tstep : cA; const char* nB = has_next ? (const char*)g.Bt + (size_t)nxt.pn * tstep : cB;
        for (int t = 0; t < nt; t += 2) {
            const bool last = (t == nt - 2);
            const char* a1 = cA + (size_t)(t + 1) * kstep;
            const char* a2 = last ? nA : cA + (size_t)(t + 2) * kstep; const char* b2 = last ? nB : cB + (size_t)(t + 2) * kstep;
            const char* a3 = a2 + kstep; const char* b3 = b2 + kstep;
            if (last && has_next) S.a_ready(nxt);
            if constexpr (SP2) {
            PG8_LDB(B0, 0, 0); PG8_LDB(B1, 0, 1); PG8_SCHED; PG8_LDA(At, 0, 0); PG8_STAGE(PG8_SA(1, 1), a1 + hstep, voffA);
            PG8_WAIT_V(8); PG8_WAIT_L(0); PG8_BAR; PG8_MMA(0, 0, At, B0); PG8_MMA(0, 1, At, B1); PG8_BAR; PG8_SCHED;
            PG8_LDA(At, 0, 1); PG8_STAGE(PG8_SB(0, 0), b2, voffB); PG8_STAGE(PG8_SB(0, 1), b2 + hstep, voffB); PG8_STAGE(PG8_SA(0, 0), a2, voffA);
            PG8_WAIT_V(8); PG8_WAIT_L(0); PG8_BAR; PG8_MMA(1, 0, At, B0); PG8_MMA(1, 1, At, B1); PG8_BAR; PG8_SCHED;
            PG8_LDB(B0, 1, 0); PG8_LDB(B1, 1, 1); PG8_SCHED; PG8_LDA(At, 1, 0); PG8_STAGE(PG8_SA(0, 1), a2 + hstep, voffA);
            PG8_WAIT_V(8); PG8_WAIT_L(0); PG8_BAR; PG8_MMA(0, 0, At, B0); PG8_MMA(0, 1, At, B1); PG8_BAR; PG8_SCHED;
            PG8_LDA(At, 1, 1); PG8_STAGE(PG8_SB(1, 0), b3, voffB); PG8_STAGE(PG8_SB(1, 1), b3 + hstep, voffB); PG8_STAGE(PG8_SA(1, 0), a3, voffA);
            PG8_WAIT_V(8); PG8_WAIT_L(0); PG8_BAR; PG8_MMA(1, 0, At, B0); PG8_MMA(1, 1, At, B1); PG8_BAR; PG8_SCHED;
            } else {
            PG8_LDB(B0, 0, 0); PG8_SCHED; PG8_LDA(At, 0, 0); PG8_STAGE(PG8_SA(1, 1), a1 + hstep, voffA);
            PG8_WAIT_L(8); PG8_BAR; PG8_WAIT_L(0); PG8_MMA(0, 0, At, B0); PG8_BAR; PG8_SCHED;
            PG8_LDB(B1, 0, 1); PG8_STAGE(PG8_SB(0, 0), b2, voffB);
            PG8_BAR; PG8_WAIT_L(0); PG8_MMA(0, 1, At, B1); PG8_BAR;
            PG8_LDA(At, 0, 1); PG8_STAGE(PG8_SA(0, 0), a2, voffA);
            PG8_BAR; PG8_WAIT_L(0); PG8_MMA(1, 0, At, B0); PG8_BAR; PG8_SCHED;
            PG8_STAGE(PG8_SB(0, 1), b2 + hstep, voffB);
            PG8_WAIT_V(6); PG8_BAR; PG8_MMA(1, 1, At, B1); PG8_BAR;
            PG8_LDB(B0, 1, 0); PG8_SCHED; PG8_LDA(At, 1, 0); PG8_STAGE(PG8_SA(0, 1), a2 + hstep, voffA);
            PG8_WAIT_L(8); PG8_BAR; PG8_WAIT_L(0); PG8_MMA(0, 0, At, B0); PG8_BAR; PG8_SCHED;
            PG8_LDB(B1, 1, 1); PG8_STAGE(PG8_SB(1, 0), b3, voffB);
            PG8_BAR; PG8_WAIT_L(0); PG8_MMA(0, 1, At, B1); PG8_BAR;
            PG8_LDA(At, 1, 1); PG8_STAGE(PG8_SA(1, 0), a3, voffA);
            PG8_BAR; PG8_WAIT_L(0); PG8_MMA(1, 0, At, B0); PG8_BAR; PG8_SCHED;
            PG8_STAGE(PG8_SB(1, 1), b3 + hstep, voffB);
            PG8_WAIT_V(6); PG8_BAR; PG8_MMA(1, 1, At, B1); PG8_BAR;
            }
        }
        if constexpr (ALIGN_EPI) { if (wr == 0) PG8_BAR; }
        if constexpr (!Epi::AFTER_DRAIN) { E(acc, cur, ui, wr, wc, fr, fq); S.done(cur); }
        if (!has_next) break;
#pragma unroll
        for (int a = 0; a < 2; ++a)
#pragma unroll
            for (int b = 0; b < 2; ++b)
#pragma unroll
                for (int m = 0; m < 4; ++m)
#pragma unroll
                    for (int n = 0; n < 2; ++n) acc[a][b][m][n] = (f32x4){0.f, 0.f, 0.f, 0.f};
        cur = nxt; cA = nA; cB = nB; ++ui;
        if constexpr (ALIGN_EPI) { if (wr == 1) PG8_BAR; }
    }
    PG8_WAIT_V(0);
    if constexpr (!ALIGN_EPI) { if (wr == 0) PG8_BAR; }
    PG8_BAR;
    if constexpr (Epi::AFTER_DRAIN) { E.fused(acc, cur, wr, wc, fr, fq, lds, wid, lane); S.done(cur); }
#undef PG8_SA
#undef PG8_SB
#undef PG8_STAGE
#undef PG8_LDA
#undef PG8_LDB
#undef PG8_MMA
#undef PG8_WAIT_V
#undef PG8_WAIT_L
#undef PG8_BAR
#undef PG8_SCHED
}
}


#define LAS __attribute__((address_space(3)))
#define GAS __attribute__((address_space(1)))
using pg8::bf16_t; using pg8::bf16x8; using pg8::f32x4; using pg8::u32x4; using pg8::cvt_pk_bf16; using pg8::f32x2; using pg8::gelu_pk;
typedef short s16x4 __attribute__((ext_vector_type(4)));
typedef short v4i16_t __attribute__((ext_vector_type(4)));
typedef unsigned u32x2 __attribute__((ext_vector_type(2)));
constexpr int NB = 4, T = 4096, M = NB * T, D = 1024, NL = 4;
constexpr int NIN = 2688, NPROJ = 2816, DFF = 2816, NCH = 32;
constexpr int C_QR = 0, C_KR = 384, C_VR = 768, C_GR = 1152, C_U = 1536, C_V = 1792, C_QA = 2048, C_KA = 2432, C_VA = 2560;
constexpr int MIX_RET = 0, MIX_MLP = 384, MIX_ATT = 640;
constexpr float EPS = 1e-6f;
constexpr size_t MiB = 1u << 20;
constexpr size_t WS_W1 = 1 * MiB, WS_W2 = 23 * MiB, WS_W3 = 31 * MiB, WS_W4 = 75 * MiB, WS_WSP = 97 * MiB, WS_SSQ = 98 * MiB, WS_KV = 99 * MiB,
                 WS_XB = 111 * MiB, WS_MIX = 143 * MiB, WS_PROJ = 175 * MiB, WS_END = 265 * MiB;
constexpr int LDS_BYTES = 147456, RTAB_OFF = 131072;
#ifndef WGM_G1
#define WGM_G1 4
#endif
#ifndef WGM_G3
#define WGM_G3 4
#endif
constexpr int CONV_IL = 16 * 44 + 16 * 16 + 16 * 88 + 44 * 16, CONV_SPLIT = 16 * 44 + 16 * 16;
constexpr int CONV_FIRST_WG = (64 * 22) % 256;

struct Args { const float* in[14]; float* out; unsigned char* ws; };

__device__ __forceinline__ float wave_sum(float v) {
#pragma unroll
    for (int o = 1; o < 64; o <<= 1) v += __shfl_xor(v, o);
    return v;
}
__device__ __forceinline__ void lds_barrier() { asm volatile("s_waitcnt lgkmcnt(0)" ::: "memory"); __builtin_amdgcn_s_barrier(); asm volatile("" ::: "memory"); }
template <int CTRL> __device__ __forceinline__ float dppf(float x) { return __builtin_bit_cast(float, __builtin_amdgcn_update_dpp(0, __builtin_bit_cast(int, x), CTRL, 0xf, 0xf, true)); }
__device__ __forceinline__ void wave_sum2(float& a, float& b) {
    a += dppf<0xB1>(a); b += dppf<0xB1>(b);
    a += dppf<0x4E>(a); b += dppf<0x4E>(b);
    a += dppf<0x141>(a); b += dppf<0x141>(b);
    a += dppf<0x140>(a); b += dppf<0x140>(b);
    a += __shfl_xor(a, 16); b += __shfl_xor(b, 16);
    a += __shfl_xor(a, 32); b += __shfl_xor(b, 32);
}
__device__ __forceinline__ float bf2f(unsigned short b) { return __uint_as_float(((unsigned)b) << 16); }
__device__ __forceinline__ f32x4 mfma16(bf16x8 a, bf16x8 b, f32x4 c) { return __builtin_amdgcn_mfma_f32_16x16x32_bf16(a, b, c, 0, 0, 0); }
__device__ __forceinline__ s16x4 tr_read(const LAS unsigned char* p) { return __builtin_bit_cast(s16x4, __builtin_amdgcn_ds_read_tr16_b64_v4i16((LAS v4i16_t*)p)); }
__device__ __forceinline__ bf16x8 mk8(s16x4 lo, s16x4 hi) { return (bf16x8){lo[0], lo[1], lo[2], lo[3], hi[0], hi[1], hi[2], hi[3]}; }
__device__ __forceinline__ bf16x8 pack8(f32x4 a, f32x4 b) { u32x4 w; w.x = cvt_pk_bf16(a[0], a[1]); w.y = cvt_pk_bf16(a[2], a[3]); w.z = cvt_pk_bf16(b[0], b[1]); w.w = cvt_pk_bf16(b[2], b[3]); return __builtin_bit_cast(bf16x8, w); }
__device__ __forceinline__ u32x2 pack4(f32x4 a) { u32x2 w; w.x = cvt_pk_bf16(a[0], a[1]); w.y = cvt_pk_bf16(a[2], a[3]); return w; }
__device__ __forceinline__ f32x4 unpack4(u32x2 w) { return (f32x4){__uint_as_float(w.x << 16), __uint_as_float(w.x & 0xffff0000u), __uint_as_float(w.y << 16), __uint_as_float(w.y & 0xffff0000u)}; }

struct EpiProj {
    static constexpr bool PERM = true, AFTER_DRAIN = false;
    GAS bf16_t* O; const LAS float* rtab;
    __device__ __forceinline__ void operator()(const f32x4 (&acc)[2][2][4][2], const pg8::Unit& u, int ui, int wr, int wc, int fr, int fq) const {
        const int row0 = u.pm * 256 + wr * 64 + fr, col0 = u.pn * 256 + wc * 32 + 8 * fq;
        const bool gl = (u.pn == 6 || u.pn == 7);
#pragma unroll
        for (int ai = 0; ai < 2; ++ai)
#pragma unroll
            for (int m = 0; m < 4; ++m) {
                const float rs = rtab[ui * 256 + wr * 64 + fr + ai * 128 + m * 16];
                GAS bf16_t* rowp = O + (size_t)(row0 + ai * 128 + m * 16) * NPROJ + col0;
#pragma unroll
                for (int bj = 0; bj < 2; ++bj) {
                    f32x4 v0 = acc[ai][bj][m][0] * rs, v1 = acc[ai][bj][m][1] * rs;
                    if (gl) { f32x2 a = gelu_pk((f32x2){v0[0], v0[1]}), b = gelu_pk((f32x2){v0[2], v0[3]}), c = gelu_pk((f32x2){v1[0], v1[1]}), d = gelu_pk((f32x2){v1[2], v1[3]});
                        v0 = (f32x4){a.x, a.y, b.x, b.y}; v1 = (f32x4){c.x, c.y, d.x, d.y}; }
                    u32x4 w; w.x = cvt_pk_bf16(v0[0], v0[1]); w.y = cvt_pk_bf16(v0[2], v0[3]); w.z = cvt_pk_bf16(v1[0], v1[1]); w.w = cvt_pk_bf16(v1[2], v1[3]);
                    *(GAS u32x4*)(rowp + bj * 128) = w;
                }
            }
    }
};
struct EpiSwiGLU {
    static constexpr bool PERM = true, AFTER_DRAIN = false;
    GAS bf16_t* O; const LAS float* rtab;
    __device__ __forceinline__ void operator()(const f32x4 (&acc)[2][2][4][2], const pg8::Unit& u, int ui, int wr, int wc, int fr, int fq) const {
        const int row0 = u.pm * 256 + wr * 64 + fr, col0 = u.pn * 128 + wc * 32 + 8 * fq;
#pragma unroll
        for (int ai = 0; ai < 2; ++ai)
#pragma unroll
            for (int m = 0; m < 4; ++m) {
                const float rs = rtab[ui * 256 + wr * 64 + fr + ai * 128 + m * 16];
                f32x4 h[2];
#pragma unroll
                for (int n = 0; n < 2; ++n) {
                    const f32x4 a = acc[ai][0][m][n] * rs, b = acc[ai][1][m][n] * rs;
#pragma unroll
                    for (int j = 0; j < 4; ++j) h[n][j] = a[j] * b[j] * __builtin_amdgcn_rcpf(1.0f + __expf(-a[j]));
                }
                u32x4 w; w.x = cvt_pk_bf16(h[0][0], h[0][1]); w.y = cvt_pk_bf16(h[0][2], h[0][3]); w.z = cvt_pk_bf16(h[1][0], h[1][1]); w.w = cvt_pk_bf16(h[1][2], h[1][3]);
                *(GAS u32x4*)(O + (size_t)(row0 + ai * 128 + m * 16) * DFF + col0) = w;
            }
    }
};
struct EpiResid {
    static constexpr bool PERM = true, AFTER_DRAIN = false;
    GAS bf16_t* xb; GAS float* ssq;
    __device__ __forceinline__ void operator()(const f32x4 (&acc)[2][2][4][2], const pg8::Unit& u, int ui, int wr, int wc, int fr, int fq) const {
        const int row0 = u.pm * 256 + wr * 64 + fr, col0 = u.pn * 256 + wc * 32 + 8 * fq;
#pragma unroll
        for (int ai = 0; ai < 2; ++ai) {
            u32x4 w[4][2];
#pragma unroll
            for (int m = 0; m < 4; ++m)
#pragma unroll
                for (int bj = 0; bj < 2; ++bj) w[m][bj] = *(const GAS u32x4*)(xb + (size_t)(row0 + ai * 128 + m * 16) * D + col0 + bj * 128);
#pragma unroll
            for (int m = 0; m < 4; ++m) {
                const int row = row0 + ai * 128 + m * 16; const size_t off = (size_t)row * D + col0; float q = 0.f;
#pragma unroll
                for (int bj = 0; bj < 2; ++bj) {
                    const f32x4 o0 = unpack4((u32x2){w[m][bj].x, w[m][bj].y}) + acc[ai][bj][m][0], o1 = unpack4((u32x2){w[m][bj].z, w[m][bj].w}) + acc[ai][bj][m][1];
                    *(GAS bf16x8*)(xb + off + bj * 128) = pack8(o0, o1);
                    q += ((o0[0] * o0[0] + o0[1] * o0[1]) + (o0[2] * o0[2] + o0[3] * o0[3])) + ((o1[0] * o1[0] + o1[1] * o1[1]) + (o1[2] * o1[2] + o1[3] * o1[3]));
                }
                q += __shfl_xor(q, 16); q += __shfl_xor(q, 32);
                if (fq == 0) ssq[(size_t)(u.pn * 4 + wc) * M + row] = q;
            }
            asm volatile("" ::: "memory");
        }
    }
};

__device__ __forceinline__ void build_rtab(LAS float* rtab, const pg8::StaticOrder& S, const GAS float* ssq, int tid) {
    float p[3][16]; bool ok[3];
#pragma unroll
    for (int k = 0; k < 3; ++k) { const int idx = tid + 512 * k; pg8::Unit u; ok[k] = S.next(idx >> 8, u);
        if (ok[k]) { const int row = u.pm * 256 + (idx & 255);
#pragma unroll
            for (int j = 0; j < 16; ++j) p[k][j] = ssq[(size_t)j * M + row]; } }
#pragma unroll
    for (int k = 0; k < 3; ++k) if (ok[k]) { float s = 0.f;
#pragma unroll
        for (int j = 0; j < 16; ++j) s += p[k][j];
        rtab[tid + 512 * k] = rsqrtf(s * (1.0f / D) + EPS); }
    for (int idx = tid + 1536; idx < 16 * 256; idx += 512) {
        pg8::Unit u; if (!S.next(idx >> 8, u)) break;
        const int row = u.pm * 256 + (idx & 255); float s = 0.f;
#pragma unroll
        for (int j = 0; j < 16; ++j) s += ssq[(size_t)j * M + row];
        rtab[idx] = rsqrtf(s * (1.0f / D) + EPS);
    }
    __syncthreads();
}

constexpr int TS = 136;
__device__ __forceinline__ void transpose_item(const GAS float* W, int N, int K, int srccol0, float cscale, const GAS float* gk, GAS bf16_t* WT, int drow0, int k0, LAS unsigned char* scr, int lane) {
    const int g4 = lane >> 4, i16 = lane & 15;
    if (srccol0 < 0) {
        const u32x4 z = (u32x4){0u, 0u, 0u, 0u};
#pragma unroll
        for (int nb = 0; nb < 4; ++nb) { GAS bf16_t* o = WT + (size_t)(drow0 + nb * 16 + i16) * K + k0 + 16 * g4; *(GAS u32x4*)o = z; *(GAS u32x4*)(o + 8) = z; }
        return;
    }
    f32x4 v[16];
#pragma unroll
    for (int it = 0; it < 16; ++it) v[it] = *(const GAS f32x4*)(W + (size_t)(k0 + 4 * it + g4) * N + srccol0 + 4 * i16);
#pragma unroll
    for (int it = 0; it < 16; ++it) { const float sc = gk ? gk[k0 + 4 * it + g4] * cscale : cscale;
        *(LAS u32x2*)(scr + (4 * it + g4) * TS + i16 * 8) = pack4(v[it] * sc); }
    asm volatile("s_waitcnt lgkmcnt(0)" ::: "memory");
#pragma unroll
    for (int nb = 0; nb < 4; ++nb) {
        const LAS unsigned char* p = scr + (16 * g4 + (i16 >> 2)) * TS + (nb * 16 + 4 * (i16 & 3)) * 2;
        const s16x4 r0 = tr_read(p), r1 = tr_read(p + 4 * TS), r2 = tr_read(p + 8 * TS), r3 = tr_read(p + 12 * TS);
        GAS bf16_t* o = WT + (size_t)(drow0 + nb * 16 + i16) * K + k0 + 16 * g4;
        *(GAS bf16x8*)o = mk8(r0, r1); *(GAS bf16x8*)(o + 8) = mk8(r2, r3);
    }
    asm volatile("s_waitcnt lgkmcnt(0)" ::: "memory");
}

__device__ __forceinline__ void convert_layer_items(const GAS float* n1g, const GAS float* win, const GAS float* wout, const GAS float* n2g, const GAS float* wfi, const GAS float* wfo, GAS unsigned char* ws, int l, int first, int stride, LAS unsigned char* scr, int lane, int lo = 0, int hi = CONV_IL) {
    constexpr int I1 = 16 * 44, I2 = 16 * 16, I3 = 16 * 88, I4 = 44 * 16;
    for (int it = lo + first; it < hi; it += stride) {
        int r = it;
        if (r < I1) { const int kb = r / 44, nb = r % 44, n0 = 64 * nb;
            const float cs = ((n0 >= C_KR && n0 < C_VR) || (n0 >= C_QA && n0 < C_KA)) ? 0.125f : 1.0f;
            transpose_item(win + (size_t)l * D * NIN, NIN, D, n0 < NIN ? n0 : -1, cs, n1g + l * D, (GAS bf16_t*)(ws + WS_W1) + (size_t)l * NPROJ * D, n0, 64 * kb, scr, lane); continue; }
        r -= I1;
        if (r < I2) { const int kb = r / 16, nb = r % 16;
            transpose_item(wout + (size_t)l * D * D, D, D, 64 * nb, 1.0f, nullptr, (GAS bf16_t*)(ws + WS_W2) + (size_t)l * D * D, 64 * nb, 64 * kb, scr, lane); continue; }
        r -= I2;
        if (r < I3) { const int kb = r / 88, nb = r % 88, n0 = 64 * nb, pn = n0 >> 8, bj = (n0 >> 7) & 1, j = n0 & 127;
            transpose_item(wfi + (size_t)l * D * 2 * DFF, 2 * DFF, D, bj * DFF + 128 * pn + j, 1.0f, n2g + l * D, (GAS bf16_t*)(ws + WS_W3) + (size_t)l * 2 * DFF * D, n0, 64 * kb, scr, lane); continue; }
        r -= I3;
        { const int kb = r / 16, nb = r % 16;
            transpose_item(wfo + (size_t)l * DFF * D, D, DFF, 64 * nb, 1.0f, nullptr, (GAS bf16_t*)(ws + WS_W4) + (size_t)l * D * DFF, 64 * nb, 64 * kb, scr, lane); }
    }
}

__device__ __forceinline__ void prologue(const Args& a, LAS unsigned char* lds, int tid) {
    const int lane = tid & 63, wave = tid >> 6, G = gridDim.x;
    const int gw = blockIdx.x * 8 + wave, NGW = G * 8;
    GAS unsigned char* ws = (GAS unsigned char*)a.ws;
    convert_layer_items((const GAS float*)a.in[1], (const GAS float*)a.in[2], (const GAS float*)a.in[9], (const GAS float*)a.in[10], (const GAS float*)a.in[11], (const GAS float*)a.in[12], ws, 0, gw, NGW, lds + wave * 16384, lane, 0, CONV_SPLIT);
    { const GAS float* wsp = (const GAS float*)a.in[6]; GAS bf16_t* o = (GAS bf16_t*)(ws + WS_WSP);
      for (int i = blockIdx.x * 512 + tid; i < NL * 4 * 128 * 128 / 2; i += G * 512) { const int e = 2 * i, jj = e & 127, ii = (e >> 7) & 127;
          const float w0 = jj <= ii ? wsp[e] : 0.f, w1 = (jj + 1) <= ii ? wsp[e + 1] : 0.f; ((GAS unsigned*)o)[i] = cvt_pk_bf16(w0, w1); } }
    { const GAS float* x = (const GAS float*)a.in[0]; GAS bf16_t* xb = (GAS bf16_t*)(ws + WS_XB); GAS float* ssq = (GAS float*)(ws + WS_SSQ);
      for (int row0 = gw; row0 < M; row0 += 4 * NGW) {
          f32x4 v[4][4]; float s[4];
#pragma unroll
          for (int r = 0; r < 4; ++r) { const int row = row0 + r * NGW; if (row < M) { const GAS f32x4* xr = (const GAS f32x4*)(x + (size_t)row * D);
#pragma unroll
              for (int j = 0; j < 4; ++j) v[r][j] = xr[64 * j + lane]; } }
#pragma unroll
          for (int r = 0; r < 4; ++r) { s[r] = 0.f;
#pragma unroll
              for (int j = 0; j < 4; ++j) s[r] += (v[r][j][0] * v[r][j][0] + v[r][j][1] * v[r][j][1]) + (v[r][j][2] * v[r][j][2] + v[r][j][3] * v[r][j][3]); }
          wave_sum2(s[0], s[1]); wave_sum2(s[2], s[3]);
#pragma unroll
          for (int r = 0; r < 4; ++r) { const int row = row0 + r * NGW; if (row < M) { GAS u32x2* o8 = (GAS u32x2*)(xb + (size_t)row * D);
#pragma unroll
              for (int j = 0; j < 4; ++j) o8[64 * j + lane] = pack4(v[r][j]);
              if (lane < 16) ssq[(size_t)lane * M + row] = (lane == 0) ? s[r] : 0.f; } }
      } }
}
__device__ __forceinline__ void final_norm(GAS float* out, const GAS bf16_t* xb, const GAS float* ssq, const GAS float* gfp, int tid) {
    const int lane = tid & 63, wave = tid >> 6, gw = blockIdx.x * 8 + wave, NGW = gridDim.x * 8;
    f32x4 gf[4];
#pragma unroll
    for (int j = 0; j < 2; ++j) { gf[2 * j] = *(const GAS f32x4*)(gfp + 8 * (64 * j + lane)); gf[2 * j + 1] = *(const GAS f32x4*)(gfp + 8 * (64 * j + lane) + 4); }
    for (int row0 = gw; row0 < M; row0 += 4 * NGW) {
        float s[4]; u32x4 w[4][2];
#pragma unroll
        for (int r = 0; r < 4; ++r) { const int row = row0 + r * NGW; s[r] = 0.f; if (row < M) { s[r] = (lane < 16) ? ssq[(size_t)lane * M + row] : 0.f;
            const GAS u32x4* xr = (const GAS u32x4*)(xb + (size_t)row * D); w[r][0] = xr[lane]; w[r][1] = xr[64 + lane]; } }
        wave_sum2(s[0], s[1]); wave_sum2(s[2], s[3]);
#pragma unroll
        for (int r = 0; r < 4; ++r) { const int row = row0 + r * NGW; if (row < M) { const float rs = rsqrtf(s[r] * (1.0f / D) + EPS); GAS f32x4* orow = (GAS f32x4*)(out + (size_t)row * D);
#pragma unroll
            for (int j = 0; j < 2; ++j) { orow[2 * (64 * j + lane)] = unpack4((u32x2){w[r][j].x, w[r][j].y}) * rs * gf[2 * j]; orow[2 * (64 * j + lane) + 1] = unpack4((u32x2){w[r][j].z, w[r][j].w}) * rs * gf[2 * j + 1]; } } }
    }
}


constexpr int MISC_OFF = 139264;
constexpr int RS = 144;
constexpr int VS = 528;
constexpr size_t WS_TOT = 263 * MiB;

constexpr int WSCR_OFF = 118784, WSCR_STRIDE = 144, WSCR_BYTES = 16 * WSCR_STRIDE;
__device__ __forceinline__ void store_tile16x64(LAS unsigned char* wscr, const u32x2 (&pk)[4], GAS bf16_t* dst  , int lane) {
    const int g4 = lane >> 4, i16 = lane & 15;
#pragma unroll
    for (int et = 0; et < 4; ++et) *(LAS u32x2*)(wscr + i16 * WSCR_STRIDE + et * 32 + g4 * 8) = pk[et];
    asm volatile("s_waitcnt lgkmcnt(0)" ::: "memory");
    u32x4 v[2];
#pragma unroll
    for (int hh = 0; hh < 2; ++hh) v[hh] = *(const LAS u32x4*)(wscr + ((lane >> 3) + 8 * hh) * WSCR_STRIDE + (lane & 7) * 16);
    asm volatile("s_waitcnt lgkmcnt(0)" ::: "memory");
#pragma unroll
    for (int hh = 0; hh < 2; ++hh) *(GAS u32x4*)(dst + (size_t)((lane >> 3) + 8 * hh) * D + (lane & 7) * 8) = v[hh];
}
__device__ __forceinline__ void store_tile16x32(LAS unsigned char* wscr, const u32x2 (&pk)[2], GAS bf16_t* dst, int lane) {
    const int g4 = lane >> 4, i16 = lane & 15;
#pragma unroll
    for (int cc = 0; cc < 2; ++cc) *(LAS u32x2*)(wscr + i16 * WSCR_STRIDE + cc * 32 + g4 * 8) = pk[cc];
    asm volatile("s_waitcnt lgkmcnt(0)" ::: "memory");
    const u32x4 v = *(const LAS u32x4*)(wscr + (lane >> 2) * WSCR_STRIDE + (lane & 3) * 16);
    asm volatile("s_waitcnt lgkmcnt(0)" ::: "memory");
    *(GAS u32x4*)(dst + (size_t)(lane >> 2) * D + (lane & 3) * 8) = v;
}

__device__ __forceinline__ void attn_job(LAS unsigned char* lds, const GAS bf16_t* proj, GAS bf16_t* mixed, const GAS float* sinks, int job, int tid) {
    const int kvh = job & 1, n = (job >> 1) & 31, b = job >> 6;
    const int lane = tid & 63, wid = tid >> 6, g4 = lane >> 4, i16 = lane & 15;
    LAS unsigned char* Kl = lds; LAS unsigned char* Vl = lds + 256 * RS;
    u32x4 kr[4], vr[4];
#pragma unroll
    for (int i = 0; i < 4; ++i) { const int c = tid + 512 * i, row = c >> 3, ch = c & 7;
        kr[i] = (u32x4){0u, 0u, 0u, 0u}; vr[i] = kr[i];
        if (n > 0 || row >= 128) { const GAS bf16_t* p = proj + (size_t)(b * T + n * 128 - 128 + row) * NPROJ; kr[i] = *(const GAS u32x4*)(p + C_KA + kvh * 64 + ch * 8); vr[i] = *(const GAS u32x4*)(p + C_VA + kvh * 64 + ch * 8); } }
    bf16x8 qf[3][2]; float sk[3];
#pragma unroll
    for (int qt = 0; qt < 3; ++qt) { const int t = wid * 3 + qt, g = t >> 3, aa = t & 7, h = kvh * 3 + g; sk[qt] = sinks[h];
        const GAS bf16_t* qp = proj + ((size_t)b * T + n * 128 + 16 * aa + i16) * NPROJ + C_QA + h * 64 + 8 * g4;
        qf[qt][0] = *(const GAS bf16x8*)qp; qf[qt][1] = *(const GAS bf16x8*)(qp + 32); }
#pragma unroll
    for (int i = 0; i < 4; ++i) { const int c = tid + 512 * i, row = c >> 3, ch = c & 7;
        *(LAS u32x4*)(Kl + row * RS + ch * 16) = kr[i]; *(LAS u32x4*)(Vl + row * RS + ch * 16) = vr[i]; }
    lds_barrier();
#pragma unroll 1
    for (int qt = 0; qt < 3; ++qt) {
        const int t = wid * 3 + qt, g = t >> 3, aa = t & 7, h = kvh * 3 + g;
        const float slope = (h == 0) ? 0.25f : (h == 1) ? 0.0625f : (h == 2) ? 0.015625f : (h == 3) ? 0.00390625f : (h == 4) ? 0.5f : 0.125f;
        const float sink = qt == 0 ? sk[0] : (qt == 1 ? sk[1] : sk[2]);
        const int iq = 16 * aa + i16; const size_t tok = (size_t)b * T + n * 128 + iq;
        const bf16x8 q0 = qt == 0 ? qf[0][0] : (qt == 1 ? qf[1][0] : qf[2][0]), q1 = qt == 0 ? qf[0][1] : (qt == 1 ? qf[1][1] : qf[2][1]);
        const int kb0 = aa >> 1;
        f32x4 s[10];
#pragma unroll
        for (int kt = 0; kt < 10; ++kt) { const LAS unsigned char* kp = Kl + ((kb0 * 2 + kt) * 16 + i16) * RS + g4 * 16;
            const bf16x8 k0 = *(const LAS bf16x8*)kp, k1 = *(const LAS bf16x8*)(kp + 64);
            f32x4 z = (f32x4){0.f, 0.f, 0.f, 0.f}; z = mfma16(k0, q0, z); z = mfma16(k1, q1, z); s[kt] = z; }
        float mx = sink;
#pragma unroll
        for (int kt = 0; kt < 10; ++kt)
#pragma unroll
            for (int r = 0; r < 4; ++r) { const int kj = (kb0 * 2 + kt) * 16 + 4 * g4 + r, dist = 128 + iq - kj;
                const bool ok = dist >= 0 && dist < 128 && (n > 0 || kj >= 128);
                const float v = ok ? s[kt][r] - slope * (float)dist : -1e30f; s[kt][r] = v; mx = fmaxf(mx, v); }
        mx = fmaxf(mx, __shfl_xor(mx, 16)); mx = fmaxf(mx, __shfl_xor(mx, 32));
        float sum = 0.f;
#pragma unroll
        for (int kt = 0; kt < 10; ++kt)
#pragma unroll
            for (int r = 0; r < 4; ++r) { const float p = __expf(s[kt][r] - mx); s[kt][r] = p; sum += p; }
        sum += __shfl_xor(sum, 16); sum += __shfl_xor(sum, 32);
        const float inv = 1.0f / (sum + __expf(sink - mx));
        f32x4 o[4];
#pragma unroll
        for (int et = 0; et < 4; ++et) o[et] = (f32x4){0.f, 0.f, 0.f, 0.f};
#pragma unroll
        for (int kb = 0; kb < 5; ++kb) { const bf16x8 pb = pack8(s[2 * kb], s[2 * kb + 1]);
#pragma unroll
            for (int et = 0; et < 4; ++et) { const LAS unsigned char* vp = Vl + ((kb0 + kb) * 32 + 4 * g4 + (i16 >> 2)) * RS + (et * 16 + 4 * (i16 & 3)) * 2;
                o[et] = mfma16(mk8(tr_read(vp), tr_read(vp + 16 * RS)), pb, o[et]); } }
        u32x2 pk[4];
#pragma unroll
        for (int et = 0; et < 4; ++et) pk[et] = pack4(o[et] * inv);
        store_tile16x64(lds + WSCR_OFF + wid * WSCR_BYTES, pk, mixed + ((size_t)b * T + n * 128 + 16 * aa) * D + MIX_ATT + h * 64, lane);
    }
}

__device__ __forceinline__ void gmlp_job(LAS unsigned char* lds, const GAS bf16_t* proj, GAS bf16_t* mixed, const GAS bf16_t* wsb, const GAS float* bsp, const GAS float* lng, const GAS float* lnb, int job, int tid) {
    const int n = job & 31, b = job >> 5;
    const int lane = tid & 63, wid = tid >> 6, g4 = lane >> 4, i16 = lane & 15;
    const size_t tok0 = (size_t)b * T + n * 128;
    const int ct0 = 2 * wid, grp = wid >> 1;
    const GAS bf16_t* wg = wsb + (size_t)grp * 128 * 128 + (size_t)i16 * 128 + 8 * g4;
    bf16x8 wf[4][8]; u32x2 ur[8][2]; float bsv[8];
    { const f32x4 gg = *(const GAS f32x4*)(lng + 4 * lane), bb = *(const GAS f32x4*)(lnb + 4 * lane);
      u32x2 xr[16];
#pragma unroll
      for (int rr = 0; rr < 16; ++rr) xr[rr] = *(const GAS u32x2*)(proj + (tok0 + 16 * wid + rr) * NPROJ + C_V + 4 * lane);
#pragma unroll
      for (int kb = 0; kb < 4; ++kb)
#pragma unroll
          for (int aa = 2 * kb; aa < 8; ++aa) wf[kb][aa] = *(const GAS bf16x8*)(wg + (size_t)(16 * aa) * 128 + 32 * kb);
#pragma unroll
      for (int aa = 0; aa < 8; ++aa) { bsv[aa] = bsp[grp * 128 + 16 * aa + i16];
#pragma unroll
          for (int cc = 0; cc < 2; ++cc) ur[aa][cc] = *(const GAS u32x2*)(proj + (tok0 + 16 * aa + i16) * NPROJ + C_U + (ct0 + cc) * 16 + 4 * g4); }
#pragma unroll
      for (int rr = 0; rr < 16; ++rr) { const int row = 16 * wid + rr;
          const f32x4 x = unpack4(xr[rr]);
          float s1 = (x[0] + x[1]) + (x[2] + x[3]), s2 = (x[0] * x[0] + x[1] * x[1]) + (x[2] * x[2] + x[3] * x[3]);
          wave_sum2(s1, s2);
          const float mu = s1 * (1.0f / 256.0f);
          const f32x4 d = x - mu;
          const float var = fmaxf(s2 * (1.0f / 256.0f) - mu * mu, 0.f);
          const float rs = rsqrtf(var + EPS);
          *(LAS u32x2*)(lds + row * VS + lane * 8) = pack4(d * rs * gg + bb); } }
    lds_barrier();
    f32x4 acc[8][2];
#pragma unroll
    for (int aa = 0; aa < 8; ++aa) { acc[aa][0] = (f32x4){0.f, 0.f, 0.f, 0.f}; acc[aa][1] = acc[aa][0]; }
#pragma unroll
    for (int kb = 0; kb < 4; ++kb) {
        bf16x8 af[2];
#pragma unroll
        for (int cc = 0; cc < 2; ++cc) { const LAS unsigned char* vp = lds + (32 * kb + 8 * g4 + (i16 >> 2)) * VS + ((ct0 + cc) * 16 + 4 * (i16 & 3)) * 2; af[cc] = mk8(tr_read(vp), tr_read(vp + 4 * VS)); }
#pragma unroll
        for (int aa = 2 * kb; aa < 8; ++aa)
#pragma unroll
            for (int cc = 0; cc < 2; ++cc) acc[aa][cc] = mfma16(af[cc], wf[kb][aa], acc[aa][cc]);
    }
#pragma unroll
    for (int aa = 0; aa < 8; ++aa) {
        u32x2 pk[2];
#pragma unroll
        for (int cc = 0; cc < 2; ++cc) pk[cc] = pack4(unpack4(ur[aa][cc]) * (acc[aa][cc] + bsv[aa]));
        store_tile16x32(lds + WSCR_OFF + wid * WSCR_BYTES, pk, mixed + (tok0 + 16 * aa) * D + MIX_MLP + ct0 * 16, lane);
    }
}

__device__ __forceinline__ void kvoct_job(LAS unsigned char* lds, const GAS bf16_t* proj, GAS float* Pb, GAS float* Tot, int job, int tid) {
    const int o = job & 3, h = (job >> 2) % 6, b = job / 24;
    const int lane = tid & 63, wid = tid >> 6, g4 = lane >> 4, i16 = lane & 15;
    const float lg2 = log2f(1.0f - exp2f(-5.0f - (float)h)), cd = exp2f(lg2 * 128.0f);
    const int et = wid >> 1, dt0 = (wid & 1) * 2;
    const int row0 = tid >> 3, ch = tid & 7;
    const float tl0 = exp2f(lg2 * (float)(127 - row0)), tl1 = exp2f(lg2 * (float)(63 - row0));
    const GAS bf16_t* src = proj + ((size_t)b * T + (size_t)(8 * o) * 128 + row0) * NPROJ + h * 64 + ch * 8;
    u32x4 kk[4][2], vv[4][2];
#pragma unroll
    for (int s = 0; s < 4; ++s) { const GAS bf16_t* s2 = src + (size_t)s * 128 * NPROJ;
        kk[s][0] = *(const GAS u32x4*)(s2 + C_KR); vv[s][0] = *(const GAS u32x4*)(s2 + C_VR); kk[s][1] = *(const GAS u32x4*)(s2 + (size_t)64 * NPROJ + C_KR); vv[s][1] = *(const GAS u32x4*)(s2 + (size_t)64 * NPROJ + C_VR); }
    f32x4 P[2]; P[0] = (f32x4){0.f, 0.f, 0.f, 0.f}; P[1] = P[0];
    GAS float* po = Pb + ((size_t)((b * 6 + h) * 32 + 8 * o)) * 4096 + (et * 16 + i16) * 64 + dt0 * 16 + 4 * g4;
#pragma unroll
    for (int c = 0; c < 8; ++c) {
        const int s = c & 3;
        LAS unsigned char* Kl = lds + (c & 1) * (256 * RS); LAS unsigned char* Vl = Kl + 128 * RS;
        *(LAS bf16x8*)(Kl + row0 * RS + ch * 16) = pack8(unpack4((u32x2){kk[s][0].x, kk[s][0].y}) * tl0, unpack4((u32x2){kk[s][0].z, kk[s][0].w}) * tl0);
        *(LAS bf16x8*)(Kl + (row0 + 64) * RS + ch * 16) = pack8(unpack4((u32x2){kk[s][1].x, kk[s][1].y}) * tl1, unpack4((u32x2){kk[s][1].z, kk[s][1].w}) * tl1);
        *(LAS u32x4*)(Vl + row0 * RS + ch * 16) = vv[s][0]; *(LAS u32x4*)(Vl + (row0 + 64) * RS + ch * 16) = vv[s][1];
        if (c + 4 < 8) { const GAS bf16_t* s2 = src + (size_t)(c + 4) * 128 * NPROJ;
            kk[s][0] = *(const GAS u32x4*)(s2 + C_KR); vv[s][0] = *(const GAS u32x4*)(s2 + C_VR); kk[s][1] = *(const GAS u32x4*)(s2 + (size_t)64 * NPROJ + C_KR); vv[s][1] = *(const GAS u32x4*)(s2 + (size_t)64 * NPROJ + C_VR); }
        lds_barrier();
        *(GAS f32x4*)(po + (size_t)c * 4096) = P[0]; *(GAS f32x4*)(po + (size_t)c * 4096 + 16) = P[1];
        f32x4 acc[2]; acc[0] = (f32x4){0.f, 0.f, 0.f, 0.f}; acc[1] = acc[0];
#pragma unroll
        for (int ks = 0; ks < 4; ++ks) {
            const int rowb = 32 * ks + 8 * g4 + (i16 >> 2);
            const LAS unsigned char* vp = Vl + rowb * RS + (et * 16 + 4 * (i16 & 3)) * 2;
            const bf16x8 vf = mk8(tr_read(vp), tr_read(vp + 4 * RS));
#pragma unroll
            for (int dd = 0; dd < 2; ++dd) { const LAS unsigned char* kp = Kl + rowb * RS + ((dt0 + dd) * 16 + 4 * (i16 & 3)) * 2;
                acc[dd] = mfma16(mk8(tr_read(kp), tr_read(kp + 4 * RS)), vf, acc[dd]); }
        }
        P[0] = P[0] * cd + acc[0]; P[1] = P[1] * cd + acc[1];
    }
    GAS float* to = Tot + ((size_t)((b * 6 + h) * 4 + o)) * 4096 + (et * 16 + i16) * 64 + dt0 * 16 + 4 * g4;
    *(GAS f32x4*)to = P[0]; *(GAS f32x4*)(to + 16) = P[1];
}

struct RetRegs { u32x4 k0, k1, v0, v1; f32x4 s0, s1, t0[3], t1[3]; bf16x8 q0, q1; u32x2 gtr[4]; f32x4 rg[4]; };
constexpr int RET_BUF = 320 * RS;
__device__ __forceinline__ void ret_load(RetRegs& R, const GAS bf16_t* proj, const GAS float* Pb, const GAS float* Tot, const GAS float* retg, int job, int tid) {
    const int n = job & 31, h = (job >> 5) % 6, b = job / 192;
    const int lane = tid & 63, wid = tid >> 6, g4 = lane >> 4, i16 = lane & 15;
    const size_t tok0 = (size_t)b * T + n * 128, tok = tok0 + 16 * wid + i16;
    const int row0 = tid >> 3, ch = tid & 7;
    const GAS bf16_t* src = proj + (tok0 + row0) * NPROJ + h * 64 + ch * 8;
    R.k0 = *(const GAS u32x4*)(src + C_KR); R.v0 = *(const GAS u32x4*)(src + C_VR); R.k1 = *(const GAS u32x4*)(src + (size_t)64 * NPROJ + C_KR); R.v1 = *(const GAS u32x4*)(src + (size_t)64 * NPROJ + C_VR);
    const int oc = n >> 3;
    const GAS float* pp = Pb + ((size_t)((b * 6 + h) * 32 + n)) * 4096 + tid * 8;
    R.s0 = *(const GAS f32x4*)pp; R.s1 = *(const GAS f32x4*)(pp + 4);
#pragma unroll
    for (int oo = 0; oo < 3; ++oo) { const int os = oo < oc ? oo : 0; const GAS float* tp = Tot + ((size_t)((b * 6 + h) * 4 + os)) * 4096 + tid * 8;
        R.t0[oo] = *(const GAS f32x4*)tp; R.t1[oo] = *(const GAS f32x4*)(tp + 4); }
    const GAS bf16_t* qp = proj + tok * NPROJ + C_QR + h * 64 + 8 * g4;
    R.q0 = *(const GAS bf16x8*)qp; R.q1 = *(const GAS bf16x8*)(qp + 32);
#pragma unroll
    for (int et = 0; et < 4; ++et) { const int c = h * 64 + et * 16 + 4 * g4; R.gtr[et] = *(const GAS u32x2*)(proj + tok * NPROJ + C_GR + c); R.rg[et] = *(const GAS f32x4*)(retg + c); }
}
__device__ __forceinline__ void ret_stage(const RetRegs& R, LAS unsigned char* buf, int job, int tid) {
    const int n = job & 31, h = (job >> 5) % 6, oc = n >> 3;
    const float lg2 = log2f(1.0f - exp2f(-5.0f - (float)h));
    LAS unsigned char* Kl = buf; LAS unsigned char* Vl = buf + 128 * RS; LAS unsigned char* Sl = buf + 256 * RS;
    const int row0 = tid >> 3, ch = tid & 7;
    *(LAS u32x4*)(Kl + row0 * RS + ch * 16) = R.k0; *(LAS u32x4*)(Kl + (row0 + 64) * RS + ch * 16) = R.k1;
    *(LAS u32x4*)(Vl + row0 * RS + ch * 16) = R.v0; *(LAS u32x4*)(Vl + (row0 + 64) * RS + ch * 16) = R.v1;
    f32x4 s0 = R.s0, s1 = R.s1;
#pragma unroll
    for (int oo = 0; oo < 3; ++oo) { const float tf = oo < oc ? exp2f(lg2 * 128.0f * (float)(n - 8 * (oo + 1))) : 0.f; s0 = s0 + R.t0[oo] * tf; s1 = s1 + R.t1[oo] * tf; }
    *(LAS bf16x8*)(Sl + (tid >> 3) * RS + (tid & 7) * 16) = pack8(s0, s1);
}
__device__ __forceinline__ void ret_compute(const RetRegs& R, const LAS unsigned char* buf, LAS unsigned char* wscr, GAS bf16_t* mixed, int job, int tid) {
    const int n = job & 31, h = (job >> 5) % 6, b = job / 192;
    const int lane = tid & 63, wid = tid >> 6, g4 = lane >> 4, i16 = lane & 15;
    const float lg2 = log2f(1.0f - exp2f(-5.0f - (float)h));
    const LAS unsigned char* Kl = buf; const LAS unsigned char* Vl = buf + 128 * RS; const LAS unsigned char* Sl = buf + 256 * RS;
    const int aa = wid, iq = 16 * aa + i16; const size_t tok = (size_t)b * T + n * 128 + iq;
    const bf16x8 q0 = R.q0, q1 = R.q1;
    f32x4 o[4];
#pragma unroll
    for (int et = 0; et < 4; ++et) o[et] = (f32x4){0.f, 0.f, 0.f, 0.f};
    f32x4 s[4][2];
#pragma unroll
    for (int kb = 0; kb < 4; ++kb)
#pragma unroll
        for (int tt = 0; tt < 2; ++tt) { const LAS unsigned char* kp = Kl + ((2 * kb + tt) * 16 + i16) * RS + g4 * 16;
            const bf16x8 ka = *(const LAS bf16x8*)kp, kb2 = *(const LAS bf16x8*)(kp + 64);
            f32x4 z = (f32x4){0.f, 0.f, 0.f, 0.f}; z = mfma16(ka, q0, z); z = mfma16(kb2, q1, z); s[kb][tt] = z; }
#pragma unroll
    for (int kb = 0; kb < 4; ++kb)
#pragma unroll
        for (int tt = 0; tt < 2; ++tt)
#pragma unroll
            for (int r = 0; r < 4; ++r) { const int dl = iq - ((2 * kb + tt) * 16 + 4 * g4 + r); s[kb][tt][r] = dl >= 0 ? s[kb][tt][r] * __builtin_amdgcn_exp2f(lg2 * (float)dl) : 0.f; }
#pragma unroll
    for (int kb = 0; kb < 4; ++kb) {
        const bf16x8 pb = pack8(s[kb][0], s[kb][1]);
#pragma unroll
        for (int et = 0; et < 4; ++et) { const LAS unsigned char* vp = Vl + (kb * 32 + 4 * g4 + (i16 >> 2)) * RS + (et * 16 + 4 * (i16 & 3)) * 2;
            o[et] = mfma16(mk8(tr_read(vp), tr_read(vp + 16 * RS)), pb, o[et]); }
    }
    { const float hd = exp2f(lg2 * (float)(iq + 1));
#pragma unroll
      for (int et = 0; et < 4; ++et) { const LAS unsigned char* sp = Sl + (et * 16 + i16) * RS + g4 * 16;
          f32x4 z = (f32x4){0.f, 0.f, 0.f, 0.f}; z = mfma16(*(const LAS bf16x8*)sp, q0, z); z = mfma16(*(const LAS bf16x8*)(sp + 64), q1, z);
          o[et] = o[et] + z * hd; } }
    float ss = 0.f;
#pragma unroll
    for (int et = 0; et < 4; ++et) ss += (o[et][0] * o[et][0] + o[et][1] * o[et][1]) + (o[et][2] * o[et][2] + o[et][3] * o[et][3]);
    ss += __shfl_xor(ss, 16); ss += __shfl_xor(ss, 32);
    const float rinv = rsqrtf(ss * (1.0f / 64.0f) + EPS);
    u32x2 pk[4];
#pragma unroll
    for (int et = 0; et < 4; ++et) {
        const f32x4 gt = unpack4(R.gtr[et]);
        f32x4 y;
#pragma unroll
        for (int r = 0; r < 4; ++r) y[r] = o[et][r] * rinv * R.rg[et][r] * gt[r] * __builtin_amdgcn_rcpf(1.0f + __expf(-gt[r]));
        pk[et] = pack4(y); }
    store_tile16x64(wscr, pk, mixed + ((size_t)b * T + n * 128 + 16 * aa) * D + MIX_RET + h * 64, lane);
}

#define RLX_AGENT __ATOMIC_RELAXED, __HIP_MEMORY_SCOPE_AGENT
#define XB_TMO      128
#define XB_XCNT(j)  (256  + 64 * (j))
#define XB_XSUB(j)  (1280 + 64 * (j))
#define XB_XGEN(j)  (2304 + 64 * (j))
#define XB_TOP      3328
#define XB_TOPGEN   3392
#define XCD_BAR_WORDS 3456
#define XB_SPIN_CAP (1u << 18)

__device__ __forceinline__ unsigned xb_ld(unsigned* p)              { return __hip_atomic_load(p, __ATOMIC_RELAXED, __HIP_MEMORY_SCOPE_AGENT); }
__device__ __forceinline__ unsigned xb_add(unsigned* p, unsigned v) { return __hip_atomic_fetch_add(p, v, __ATOMIC_RELAXED, __HIP_MEMORY_SCOPE_AGENT); }
__device__ __forceinline__ unsigned xb_xcc_id() { return (unsigned)__builtin_amdgcn_s_getreg((3 << 11) | 20) & 0xFu; }
#define XB_SPIN(cond, bar) do { unsigned _sp = 0; while (cond) { __builtin_amdgcn_s_sleep(1); \
    if ((++_sp & 255u) == 0u) { if (xb_ld(&(bar)[XB_TMO])) break; if (_sp > XB_SPIN_CAP) { atomicAdd(&(bar)[XB_TMO], 1u); break; } } } } while (0)

struct XcdBarrier {
    unsigned* bar; unsigned x;
    volatile LAS unsigned* st;
};

__device__ __forceinline__ XcdBarrier xcd_barrier_post(unsigned* bar, volatile LAS unsigned* st) {
    XcdBarrier b; b.bar = bar; b.x = xb_xcc_id(); b.st = st;
    if (threadIdx.x == 0) (void)xb_add(&bar[XB_XCNT(b.x)], 1u);
    return b;
}
__device__ __forceinline__ void xcd_barrier_complete(unsigned* bar, unsigned x, unsigned& nloc, unsigned& nx) {
    const unsigned G = gridDim.x * gridDim.y * gridDim.z;
    unsigned sum, cnt, mine, sp = 0u;
    for (;;) {
        sum = 0u; cnt = 0u; mine = 0u;
#pragma unroll
        for (unsigned j = 0; j < 16; ++j) { const unsigned c = xb_ld(&bar[XB_XCNT(j)]); sum += c; cnt += (c > 0u) ? 1u : 0u; mine = (j == x) ? c : mine; }
        if (sum == G) break;
        __builtin_amdgcn_s_sleep(1);
        if ((++sp & 255u) == 0u) { if (xb_ld(&bar[XB_TMO])) break; if (sp > XB_SPIN_CAP) { atomicAdd(&bar[XB_TMO], 1u); break; } }
    }
    nloc = mine > 0u ? mine : 1u; nx = cnt > 0u ? cnt : 1u;
}

__device__ __forceinline__ void xcd_barrier(const XcdBarrier& b) {
    asm volatile("s_waitcnt vmcnt(0)" ::: "memory");
    __syncthreads();
    if (threadIdx.x == 0) {
        unsigned* bar = b.bar;
        __builtin_amdgcn_s_waitcnt(0);
        unsigned nloc = b.st[0], nx = b.st[1];
        if (nloc == 0u) { xcd_barrier_complete(bar, b.x, nloc, nx); b.st[0] = nloc; b.st[1] = nx; }
        const unsigned old = xb_add(&bar[XB_XSUB(b.x)], 1u);
        const unsigned gen = old / nloc;
        if (old + 1u == (gen + 1u) * nloc) {
            __builtin_amdgcn_fence(__ATOMIC_RELEASE, "agent");
            asm volatile("s_waitcnt vmcnt(0)" ::: "memory");
            const unsigned og = xb_add(&bar[XB_TOP], 1u);
            const unsigned tg = og / nx;
            if (og + 1u == (tg + 1u) * nx) xb_add(&bar[XB_TOPGEN], 1u);
            else XB_SPIN(xb_ld(&bar[XB_TOPGEN]) == tg, bar);
            __builtin_amdgcn_fence(__ATOMIC_ACQUIRE, "agent");
            xb_add(&bar[XB_XGEN(b.x)], 1u);
            asm volatile("s_waitcnt vmcnt(0)" ::: "memory");
        } else {
            XB_SPIN(xb_ld(&bar[XB_TOPGEN]) == gen, bar);
            __builtin_amdgcn_fence(__ATOMIC_ACQUIRE, "agent");
            asm volatile("s_waitcnt vmcnt(0)" ::: "memory");
        }
    }
    __syncthreads();
}

constexpr size_t WS_BAR = 65536;
__device__ __forceinline__ GAS unsigned char* launder_ptr(unsigned char* p) {
    unsigned lo = (unsigned)(unsigned long long)p, hi = (unsigned)((unsigned long long)p >> 32); asm volatile("" : "+v"(lo), "+v"(hi));
    lo = __builtin_amdgcn_readfirstlane(lo); hi = __builtin_amdgcn_readfirstlane(hi); return (GAS unsigned char*)(((unsigned long long)hi << 32) | lo);
}
__device__ __forceinline__ int retjob(int bb, int idx, int nhalf, int k) { const int q = idx * 3 + k; return bb * 192 + (q >> 4) * 32 + nhalf + (q & 15); }
__device__ __forceinline__ void kv_wait(unsigned* kvc, int tid) {
    if (tid == 0) { unsigned sp = 0; while (__hip_atomic_load(kvc, __ATOMIC_RELAXED, __HIP_MEMORY_SCOPE_AGENT) < 96u) { __builtin_amdgcn_s_sleep(2); if (++sp > (1u << 22)) break; }
        __builtin_amdgcn_fence(__ATOMIC_ACQUIRE, "agent"); asm volatile("s_waitcnt vmcnt(0)" ::: "memory"); }
    lds_barrier();
}
#define PH(k, ...) do { int tid = threadIdx.x; asm volatile("" : "+v"(tid)); int bid_ = blockIdx.x; asm volatile("" : "+v"(bid_)); const int bid = __builtin_amdgcn_readfirstlane(bid_); (void)bid; \
    GAS unsigned char* ws = launder_ptr(a.ws); __VA_ARGS__ } while (0)
#define GSYNC() xcd_barrier(bar)
#define PTAB(i) ((const GAS float*)(((const GAS unsigned long long*)ws)[i]))
__global__ void __launch_bounds__(512, 2) fwd_mega(Args a) {
    extern __shared__ __attribute__((aligned(16))) unsigned char lds_raw[];
    LAS unsigned char* lds = (LAS unsigned char*)lds_raw;
    cg::grid_group grid = cg::this_grid();
    if (a.ws == nullptr) grid.sync();
    { volatile LAS unsigned* misc = (volatile LAS unsigned*)(lds + MISC_OFF); if (threadIdx.x < 32) misc[threadIdx.x] = 0u; __syncthreads(); }
    const XcdBarrier bar = xcd_barrier_post((unsigned*)(a.ws + WS_BAR), (volatile LAS unsigned*)(lds + MISC_OFF + 32));
    PH(6, { prologue(a, lds, tid); if (blockIdx.x == 0 && tid == 0) { _Pragma("unroll") for (int i_ = 0; i_ < 14; ++i_) ((GAS unsigned long long*)ws)[i_] = (unsigned long long)a.in[i_]; } });
    GSYNC();
#pragma unroll 1
    for (int l = 0; l < NL; ++l) {
        PH(0, {
            pg8::Gemm g{(const bf16_t*)(ws + WS_XB), (const bf16_t*)(ws + WS_W1) + (size_t)l * NPROJ * D, M, NPROJ, D}; pg8::StaticOrder S; S.init(M, NPROJ, (int)gridDim.x, bid, WGM_G1);
            LAS float* rtab = (LAS float*)(lds + RTAB_OFF);
            build_rtab(rtab, S, (const GAS float*)(ws + WS_SSQ), tid);
            EpiProj E{(GAS bf16_t*)(ws + WS_PROJ), rtab};
            pg8::gemm_phase<EpiProj, pg8::StaticOrder, true, true>(lds, g, S, E);
            if (l == 0 && bid >= 192)
                convert_layer_items(PTAB(1), PTAB(2), PTAB(9), PTAB(10), PTAB(11), PTAB(12), ws, 0, (bid - 192) * 8 + (tid >> 6), ((int)gridDim.x - 192) * 8, lds + (tid >> 6) * 16384, tid & 63, CONV_SPLIT, CONV_IL); });
        GSYNC();
        PH(1, {
            const GAS bf16_t* PROJ = (const GAS bf16_t*)(ws + WS_PROJ); GAS bf16_t* MIX = (GAS bf16_t*)(ws + WS_MIX);
            unsigned* kvcnt = (unsigned*)(ws + WS_BAR) + 4096 + 64 * l;
            const int c = bid;
            if (gridDim.x == 256) {
                unsigned* kvc = kvcnt;
                const GAS float* Pb = (const GAS float*)(ws + WS_KV); const GAS float* Tot = (const GAS float*)(ws + WS_TOT); const GAS float* retg = PTAB(3) + l * 384;
                const int xcd = c & 7, idx = c >> 3, bb = xcd >> 1, nhalf = (xcd & 1) * 16;
                const int nj = 3;
                if (c < 96) {
                    kvoct_job(lds, PROJ, (GAS float*)(ws + WS_KV), (GAS float*)(ws + WS_TOT), bb * 24 + (idx % 6) * 4 + (xcd & 1) * 2 + idx / 6, tid);
                    asm volatile("s_waitcnt vmcnt(0)" ::: "memory"); lds_barrier();
                    if (tid == 0) { __builtin_amdgcn_fence(__ATOMIC_RELEASE, "agent"); asm volatile("s_waitcnt vmcnt(0)" ::: "memory"); __hip_atomic_fetch_add(kvc, 1u, __ATOMIC_RELAXED, __HIP_MEMORY_SCOPE_AGENT); }
                } else if (c < 224) gmlp_job(lds, PROJ, MIX, (const GAS bf16_t*)(ws + WS_WSP) + (size_t)l * 4 * 128 * 128, PTAB(7) + l * 512, PTAB(4) + l * 256, PTAB(5) + l * 256, (bb << 5) | (nhalf + idx - 12), tid);
                lds_barrier();
                attn_job(lds, PROJ, MIX, PTAB(8) + l * 6, (bb << 6) | ((nhalf + (idx >> 1)) << 1) | (idx & 1), tid);
                kv_wait(kvc, tid);
                RetRegs cur;
                ret_load(cur, PROJ, Pb, Tot, retg, retjob(bb, idx, nhalf, 0), tid);
                lds_barrier();
                _Pragma("unroll 1") for (int k = 0; k < nj; ++k) {
                    LAS unsigned char* buf = lds + (k & 1) * RET_BUF;
                    ret_stage(cur, buf, retjob(bb, idx, nhalf, k), tid);
                    lds_barrier();
                    RetRegs nxt; ret_load(nxt, PROJ, Pb, Tot, retg, retjob(bb, idx, nhalf, k + 1 < nj ? k + 1 : k), tid);
                    ret_compute(cur, buf, lds + WSCR_OFF + (tid >> 6) * WSCR_BYTES, MIX, retjob(bb, idx, nhalf, k), tid);
                    cur = nxt;
                }
            } });
        GSYNC();
        PH(3, {
            pg8::Gemm g{(const bf16_t*)(ws + WS_MIX), (const bf16_t*)(ws + WS_W2) + (size_t)l * D * D, M, D, D}; pg8::StaticOrder S; S.init(M, D, (int)gridDim.x, bid);
            EpiResid E{(GAS bf16_t*)(ws + WS_XB), (GAS float*)(ws + WS_SSQ)};
            pg8::gemm_phase<EpiResid, pg8::StaticOrder, true, true>(lds, g, S, E); });
        GSYNC();
        PH(4, {
            pg8::Gemm g{(const bf16_t*)(ws + WS_XB), (const bf16_t*)(ws + WS_W3) + (size_t)l * 2 * DFF * D, M, 2 * DFF, D}; pg8::StaticOrder S; S.init(M, 2 * DFF, (int)gridDim.x, bid, WGM_G3);
            LAS float* rtab = (LAS float*)(lds + RTAB_OFF);
            build_rtab(rtab, S, (const GAS float*)(ws + WS_SSQ), tid);
            EpiSwiGLU E{(GAS bf16_t*)(ws + WS_PROJ), rtab};
            pg8::gemm_phase<EpiSwiGLU, pg8::StaticOrder, true, true>(lds, g, S, E);
            if (l + 1 < NL && bid >= CONV_FIRST_WG)
                convert_layer_items(PTAB(1), PTAB(2), PTAB(9), PTAB(10), PTAB(11), PTAB(12), ws, l + 1, (bid - CONV_FIRST_WG) * 8 + (tid >> 6), ((int)gridDim.x - CONV_FIRST_WG) * 8, lds + (tid >> 6) * 16384, tid & 63); });
        GSYNC();
        PH(5, {
            pg8::Gemm g{(const bf16_t*)(ws + WS_PROJ), (const bf16_t*)(ws + WS_W4) + (size_t)l * D * DFF, M, D, DFF}; pg8::StaticOrder S; S.init(M, D, (int)gridDim.x, bid);
            EpiResid E{(GAS bf16_t*)(ws + WS_XB), (GAS float*)(ws + WS_SSQ)};
            pg8::gemm_phase<EpiResid, pg8::StaticOrder, true, true>(lds, g, S, E); });
        GSYNC();
    }
    PH(8, { final_norm((GAS float*)a.out, (const GAS bf16_t*)(ws + WS_XB), (const GAS float*)(ws + WS_SSQ), PTAB(13), tid); });
}

extern "C" void kernel_launch(void* const* d_in, const int* in_sizes, int n_in, void* d_out, int out_size, void* d_ws, size_t ws_size, hipStream_t stream) {
    static int grid = 0;
    if (grid == 0) {
        if (n_in != 14 || out_size != M * D || ws_size < WS_END) { fprintf(stderr, "kernel_launch: unexpected shapes (n_in %d, out %d, ws %zu)\n", n_in, out_size, ws_size); grid = -1; return; }
        int dev = 0, cus = 0, per_cu = 0;
        (void)hipGetDevice(&dev); (void)hipDeviceGetAttribute(&cus, hipDeviceAttributeMultiprocessorCount, dev);
        if (hipFuncSetAttribute((const void*)fwd_mega, hipFuncAttributeMaxDynamicSharedMemorySize, LDS_BYTES) != hipSuccess) { fprintf(stderr, "kernel_launch: hipFuncSetAttribute failed\n"); grid = -1; return; }
        (void)hipOccupancyMaxActiveBlocksPerMultiprocessor(&per_cu, (const void*)fwd_mega, 512, LDS_BYTES);
        (void)hipGetLastError();
        if (per_cu < 1) fprintf(stderr, "kernel_launch: occupancy query says %d blocks/CU\n", per_cu);
        grid = cus;
        if (grid != 256) fprintf(stderr, "kernel_launch: %d CUs (built for 256)\n", grid);
    }
    if (grid < 0) return;
    Args a{};
    for (int i = 0; i < 14; ++i) a.in[i] = (const float*)d_in[i];
    a.out = (float*)d_out; a.ws = (unsigned char*)d_ws;
    if (hipMemsetAsync((unsigned char*)d_ws + WS_BAR, 0, 32768, stream) != hipSuccess) { fprintf(stderr, "kernel_launch: memset of barrier words failed\n"); return; }
    void* args[] = {&a};
    hipError_t e = hipLaunchCooperativeKernel((const void*)fwd_mega, dim3(grid), dim3(512), args, LDS_BYTES, stream);
    if (e != hipSuccess) fprintf(stderr, "kernel_launch: cooperative launch failed: %s (grid %d)\n", hipGetErrorString(e), grid);
}
```

```cpp
#include <hip/hip_runtime.h>
#include <hip/hip_cooperative_groups.h>
#include <cstdio>
#include <cstdint>
namespace cg = cooperative_groups;
namespace pg8 {
#define PG8_LAS __attribute__((address_space(3)))
typedef unsigned short bf16_t;
typedef short bf16x8 __attribute__((ext_vector_type(8)));
typedef float f32x4 __attribute__((ext_vector_type(4)));
typedef unsigned u32x4 __attribute__((ext_vector_type(4)));
constexpr int BM = 256, BK = 64, HALF = 128, HTB = HALF * BK * 2  , STAGE_BYTES = 8 * HTB, NXCD = 8, WGM = 4;

__host__ __device__ __forceinline__ int lds_byte(int r, int c) { const int st = (r >> 4) * 2 + (c >> 5), rr = r & 15, cc = c & 31, ob = rr * 64 + cc * 2; return st * 1024 + (ob ^ (((ob >> 9) & 1) << 5)); }
__host__ __device__ __forceinline__ void stage_rc(int b, int& R, int& C) { const int st = b / 1024, sb = b % 1024, swz = sb ^ (((sb >> 9) & 1) << 5); R = (st >> 1) * 16 + swz / 64; C = (st & 1) * 32 + (swz % 64) / 2; }
__host__ __device__ __forceinline__ int perm32(int rho) { const int n = rho >> 4, i = rho & 15; return 8 * (i >> 2) + 4 * n + (i & 3); }

struct Unit { int pm, pn; };
struct Gemm { const bf16_t* A; const bf16_t* Bt; int M, N, K; };

struct StaticOrder {
    int nM, nN, nwg, G, c;
    __host__ __device__ void init(int M, int N, int G_, int c_) { nM = M / BM; nN = N / BM; nwg = nM * nN; G = G_; c = c_; }
    __host__ __device__ bool next(int i, Unit& u) const {
        const long L = (long)i * G + c; if (L >= nwg) return false;
        int wgid = (int)L; { const int q = nwg / NXCD, r = nwg % NXCD, xcd = wgid % NXCD, off = wgid / NXCD; wgid = (xcd < r ? xcd * (q + 1) : r * (q + 1) + (xcd - r) * q) + off; }
        const int nig = WGM * nN, gid = wgid / nig, fm = gid * WGM, gsz = (nM - fm) < WGM ? (nM - fm) : WGM;
        u.pm = fm + ((wgid % nig) % gsz); u.pn = (wgid % nig) / gsz; return true;
    }
    __device__ __forceinline__ void a_ready(const Unit&) const {}
    __device__ __forceinline__ void done(const Unit&) const {}
};
__device__ __forceinline__ unsigned cvt_pk_bf16(float lo, float hi) { unsigned r; asm volatile("v_cvt_pk_bf16_f32 %0, %1, %2" : "=v"(r) : "v"(lo), "v"(hi)); return r; }
typedef float f32x2 __attribute__((ext_vector_type(2)));
__device__ __forceinline__ f32x2 gelu_pk(f32x2 v) {
    const f32x2 av = __builtin_elementwise_abs(v), d = av * 0.2316418882f + 1.0f;
    f32x2 t; t.x = __builtin_amdgcn_rcpf(d.x); t.y = __builtin_amdgcn_rcpf(d.y);
    f32x2 q = t * 0.5307027145f + (-0.7265760135f); q = q * t + 0.7107068705f; q = q * t + (-0.142248368f); q = q * t + 0.127414796f; q = q * t;
    const f32x2 s = (v * v) * (-0.72134752044f);
    f32x2 e; e.x = __builtin_amdgcn_exp2f(s.x); e.y = __builtin_amdgcn_exp2f(s.y);
    const f32x2 m = v * (q * e), r = v - m;
    f32x2 o; o.x = v.x < 0.f ? m.x : r.x; o.y = v.y < 0.f ? m.y : r.y; return o;
}
template <class Epi, class Sched, bool ALIGN_EPI = false, bool SP2 = false>
__device__ __forceinline__ void gemm_phase(PG8_LAS unsigned char* lds, const Gemm g, const Sched& S, const Epi& E) {
    int tid_ = threadIdx.x; asm volatile("" : "+v"(tid_));
    const int tid = tid_, wid = __builtin_amdgcn_readfirstlane(tid >> 6), lane = tid & 63, wr = wid >> 2, wc = wid & 3, fr = lane & 15, fq = lane >> 4;
    const int K = g.K, nt = K / BK;
    unsigned voffA[2], voffB[2];
#pragma unroll
    for (int i = 0; i < 2; ++i) { int R, C; stage_rc(tid * 16 + i * 8192, R, C); const int Rb = Epi::PERM ? ((R & ~31) + perm32(R & 31)) : R;
        voffA[i] = (unsigned)(R * K + C) * 2u; voffB[i] = (unsigned)(Rb * K + C) * 2u; }
    const size_t kstep = (size_t)(BK * 2);
    const size_t hstep = (size_t)HALF * K * 2;
    const size_t tstep = 2 * hstep;
    const unsigned ldsw = (unsigned)wid * 1024u;
    const int aoff = lds_byte(wr * 64 + fr, fq * 8), boff = lds_byte(wc * 32 + fr, fq * 8);
#define PG8_SA(b, h) (((b) * 2 + (h)) * HTB)
#define PG8_SB(b, h) ((4 + (b) * 2 + (h)) * HTB)
#define PG8_STAGE(bufoff, gbase, voff) do { _Pragma("unroll") for (int _i = 0; _i < 2; ++_i) \
        __builtin_amdgcn_global_load_lds((const unsigned*)((const char*)(gbase) + (voff)[_i]), (PG8_LAS unsigned*)(lds + (bufoff) + ldsw + _i * 8192), 16, 0, 0); } while (0)
#define PG8_LDA(dst, b, h) do { _Pragma("unroll") for (int m = 0; m < 4; ++m) _Pragma("unroll") for (int k = 0; k < 2; ++k) dst[m][k] = *(const PG8_LAS bf16x8*)(lds + PG8_SA(b, h) + aoff + m * 2048 + k * 1024); } while (0)
#define PG8_LDB(dst, b, h) do { _Pragma("unroll") for (int n = 0; n < 2; ++n) _Pragma("unroll") for (int k = 0; k < 2; ++k) dst[n][k] = *(const PG8_LAS bf16x8*)(lds + PG8_SB(b, h) + boff + n * 2048 + k * 1024); } while (0)
#define PG8_MMA(ai, bj, At, Bt) do { __builtin_amdgcn_s_setprio(1); _Pragma("unroll") for (int m = 0; m < 4; ++m) _Pragma("unroll") for (int n = 0; n < 2; ++n) _Pragma("unroll") for (int k = 0; k < 2; ++k) \
        acc[ai][bj][m][n] = __builtin_amdgcn_mfma_f32_16x16x32_bf16(Bt[n][k], At[m][k], acc[ai][bj][m][n], 0, 0, 0); __builtin_amdgcn_s_setprio(0); } while (0)
#define PG8_WAIT_V(n) asm volatile("s_waitcnt vmcnt(" #n ")" ::: "memory")
#define PG8_WAIT_L(n) asm volatile("s_waitcnt lgkmcnt(" #n ")" ::: "memory")
#define PG8_BAR __builtin_amdgcn_s_barrier()
#define PG8_SCHED __builtin_amdgcn_sched_barrier(0)
    Unit cur, nxt; int ui = 0;
    if (!S.next(0, cur)) return;
    f32x4 acc[2][2][4][2];
#pragma unroll
    for (int a = 0; a < 2; ++a)
#pragma unroll
        for (int b = 0; b < 2; ++b)
#pragma unroll
            for (int m = 0; m < 4; ++m)
#pragma unroll
                for (int n = 0; n < 2; ++n) acc[a][b][m][n] = (f32x4){0.f, 0.f, 0.f, 0.f};
    bf16x8 At[4][2], B0[2][2], B1[2][2];
    const char* cA = (const char*)g.A + (size_t)cur.pm * tstep; const char* cB = (const char*)g.Bt + (size_t)cur.pn * tstep;
    S.a_ready(cur);
    if constexpr (SP2) {
        PG8_STAGE(PG8_SB(0, 0), cB, voffB); PG8_STAGE(PG8_SB(0, 1), cB + hstep, voffB); PG8_STAGE(PG8_SA(0, 0), cA, voffA); PG8_STAGE(PG8_SA(0, 1), cA + hstep, voffA);
        if (wr == 1) PG8_BAR;
        PG8_WAIT_V(2); PG8_BAR;
        PG8_STAGE(PG8_SB(1, 0), cB + kstep, voffB); PG8_STAGE(PG8_SA(1, 0), cA + kstep, voffA); PG8_STAGE(PG8_SB(1, 1), cB + hstep + kstep, voffB);
        PG8_WAIT_V(6); PG8_BAR;
    } else {
        PG8_STAGE(PG8_SB(0, 0), cB, voffB); PG8_STAGE(PG8_SA(0, 0), cA, voffA); PG8_STAGE(PG8_SB(0, 1), cB + hstep, voffB); PG8_STAGE(PG8_SA(0, 1), cA + hstep, voffA);
        if (wr == 1) PG8_BAR;
        PG8_WAIT_V(4); PG8_BAR;
        PG8_STAGE(PG8_SB(1, 0), cB + kstep, voffB); PG8_STAGE(PG8_SA(1, 0), cA + kstep, voffA); PG8_STAGE(PG8_SB(1, 1), cB + hstep + kstep, voffB);
        PG8_WAIT_V(6); PG8_BAR;
    }
    for (;;) {
        const bool has_next = S.next(ui + 1, nxt);
        const char* nA = has_next ? (const char*)g.A + (size_t)nxt.pm * tstep : cA; const char* nB = has_next ? (const char*)g.Bt + (size_t)nxt.pn * tstep : cB;
        for (int t = 0; t < nt; t += 2) {
            const bool last = (t == nt - 2);
            const char* a1 = cA + (size_t)(t + 1) * kstep;
            const char* a2 = last ? nA : cA + (size_t)(t + 2) * kstep; const char* b2 = last ? nB : cB + (size_t)(t + 2) * kstep;
            const char* a3 = a2 + kstep; const char* b3 = b2 + kstep;
            if (last && has_next) S.a_ready(nxt);
            if constexpr (SP2) {
            PG8_LDB(B0, 0, 0); PG8_LDB(B1, 0, 1); PG8_SCHED; PG8_LDA(At, 0, 0); PG8_STAGE(PG8_SA(1, 1), a1 + hstep, voffA);
            PG8_WAIT_V(8); PG8_WAIT_L(0); PG8_BAR; PG8_MMA(0, 0, At, B0); PG8_MMA(0, 1, At, B1); PG8_BAR; PG8_SCHED;
            PG8_LDA(At, 0, 1); PG8_STAGE(PG8_SB(0, 0), b2, voffB); PG8_STAGE(PG8_SB(0, 1), b2 + hstep, voffB); PG8_STAGE(PG8_SA(0, 0), a2, voffA);
            PG8_WAIT_V(8); PG8_WAIT_L(0); PG8_BAR; PG8_MMA(1, 0, At, B0); PG8_MMA(1, 1, At, B1); PG8_BAR; PG8_SCHED;
            PG8_LDB(B0, 1, 0); PG8_LDB(B1, 1, 1); PG8_SCHED; PG8_LDA(At, 1, 0); PG8_STAGE(PG8_SA(0, 1), a2 + hstep, voffA);
            PG8_WAIT_V(8); PG8_WAIT_L(0); PG8_BAR; PG8_MMA(0, 0, At, B0); PG8_MMA(0, 1, At, B1); PG8_BAR; PG8_SCHED;
            PG8_LDA(At, 1, 1); PG8_STAGE(PG8_SB(1, 0), b3, voffB); PG8_STAGE(PG8_SB(1, 1), b3 + hstep, voffB); PG8_STAGE(PG8_SA(1, 0), a3, voffA);
            PG8_WAIT_V(8); PG8_WAIT_L(0); PG8_BAR; PG8_MMA(1, 0, At, B0); PG8_MMA(1, 1, At, B1); PG8_BAR; PG8_SCHED;
            } else {
            PG8_LDB(B0, 0, 0); PG8_SCHED; PG8_LDA(At, 0, 0); PG8_STAGE(PG8_SA(1, 1), a1 + hstep, voffA);
            PG8_WAIT_L(8); PG8_BAR; PG8_WAIT_L(0); PG8_MMA(0, 0, At, B0); PG8_BAR; PG8_SCHED;
            PG8_LDB(B1, 0, 1); PG8_STAGE(PG8_SB(0, 0), b2, voffB);
            PG8_BAR; PG8_WAIT_L(0); PG8_MMA(0, 1, At, B1); PG8_BAR;
            PG8_LDA(At, 0, 1); PG8_STAGE(PG8_SA(0, 0), a2, voffA);
            PG8_BAR; PG8_WAIT_L(0); PG8_MMA(1, 0, At, B0); PG8_BAR; PG8_SCHED;
            PG8_STAGE(PG8_SB(0, 1), b2 + hstep, voffB);
            PG8_WAIT_V(6); PG8_BAR; PG8_MMA(1, 1, At, B1); PG8_BAR;
            PG8_LDB(B0, 1, 0); PG8_SCHED; PG8_LDA(At, 1, 0); PG8_STAGE(PG8_SA(0, 1), a2 + hstep, voffA);
            PG8_WAIT_L(8); PG8_BAR; PG8_WAIT_L(0); PG8_MMA(0, 0, At, B0); PG8_BAR; PG8_SCHED;
            PG8_LDB(B1, 1, 1); PG8_STAGE(PG8_SB(1, 0), b3, voffB);
            PG8_BAR; PG8_WAIT_L(0); PG8_MMA(0, 1, At, B1); PG8_BAR;
            PG8_LDA(At, 1, 1); PG8_STAGE(PG8_SA(1, 0), a3, voffA);
            PG8_BAR; PG8_WAIT_L(0); PG8_MMA(1, 0, At, B0); PG8_BAR; PG8_SCHED;
            PG8_STAGE(PG8_SB(1, 1), b3 + hstep, voffB);
            PG8_WAIT_V(6); PG8_BAR; PG8_MMA(1, 1, At, B1); PG8_BAR;
            }
        }
        if constexpr (ALIGN_EPI) { if (wr == 0) PG8_BAR; }
        if constexpr (!Epi::AFTER_DRAIN) { E(acc, cur, ui, wr, wc, fr, fq); S.done(cur); }
        if (!has_next) break;
#pragma unroll
        for (int a = 0; a < 2; ++a)
#pragma unroll
            for (int b = 0; b < 2; ++b)
#pragma unroll
                for (int m = 0; m < 4; ++m)
#pragma unroll
                    for (int n = 0; n < 2; ++n) acc[a][b][m][n] = (f32x4){0.f, 0.f, 0.f, 0.f};
        cur = nxt; cA = nA; cB = nB; ++ui;
        if constexpr (ALIGN_EPI) { if (wr == 1) PG8_BAR; }
    }
    PG8_WAIT_V(0);
    if constexpr (!ALIGN_EPI) { if (wr == 0) PG8_BAR; }
    PG8_BAR;
    if constexpr (Epi::AFTER_DRAIN) { E.fused(acc, cur, wr, wc, fr, fq, lds, wid, lane); S.done(cur); }
#undef PG8_SA
#undef PG8_SB
#undef PG8_STAGE
#undef PG8_LDA
#undef PG8_LDB
#undef PG8_MMA
#undef PG8_WAIT_V
#undef PG8_WAIT_L
#undef PG8_BAR
#undef PG8_SCHED
}
}


#define LAS __attribute__((address_space(3)))
#define GAS __attribute__((address_space(1)))
using pg8::bf16_t; using pg8::bf16x8; using pg8::f32x4; using pg8::u32x4; using pg8::cvt_pk_bf16; using pg8::f32x2; using pg8::gelu_pk;
typedef short s16x4 __attribute__((ext_vector_type(4)));
typedef short v4i16_t __attribute__((ext_vector_type(4)));
typedef unsigned u32x2 __attribute__((ext_vector_type(2)));
constexpr int NB = 4, T = 4096, M = NB * T, D = 1024, NL = 4;
constexpr int NIN = 2688, NPROJ = 2816, DFF = 2816, NCH = 32;
constexpr int C_QR = 0, C_KR = 384, C_VR = 768, C_GR = 1152, C_U = 1536, C_V = 1792, C_QA = 2048, C_KA = 2432, C_VA = 2560;
constexpr int MIX_RET = 0, MIX_MLP = 384, MIX_ATT = 640;
constexpr float EPS = 1e-6f;
constexpr size_t MiB = 1u << 20;
constexpr size_t WS_W1 = 1 * MiB, WS_W2 = 23 * MiB, WS_W3 = 31 * MiB, WS_W4 = 75 * MiB, WS_WSP = 97 * MiB, WS_SSQ = 98 * MiB, WS_KV = 99 * MiB,
                 WS_XB = 111 * MiB, WS_MIX = 143 * MiB, WS_PROJ = 175 * MiB, WS_END = 265 * MiB;
constexpr int LDS_BYTES = 147456, RTAB_OFF = 131072;
constexpr int CONV_IL = 16 * 44 + 16 * 16 + 16 * 88 + 44 * 16, CONV_SPLIT = 16 * 44 + 16 * 16;
constexpr int CONV_FIRST_WG = (64 * 22) % 256;

struct Args { const float* in[14]; float* out; unsigned char* ws; };

__device__ __forceinline__ float wave_sum(float v) {
#pragma unroll
    for (int o = 1; o < 64; o <<= 1) v += __shfl_xor(v, o);
    return v;
}
__device__ __forceinline__ void lds_barrier() { asm volatile("s_waitcnt lgkmcnt(0)" ::: "memory"); __builtin_amdgcn_s_barrier(); asm volatile("" ::: "memory"); }
template <int CTRL> __device__ __forceinline__ float dppf(float x) { return __builtin_bit_cast(float, __builtin_amdgcn_update_dpp(0, __builtin_bit_cast(int, x), CTRL, 0xf, 0xf, true)); }
__device__ __forceinline__ void wave_sum2(float& a, float& b) {
    a += dppf<0xB1>(a); b += dppf<0xB1>(b);
    a += dppf<0x4E>(a); b += dppf<0x4E>(b);
    a += dppf<0x141>(a); b += dppf<0x141>(b);
    a += dppf<0x140>(a); b += dppf<0x140>(b);
    a += __shfl_xor(a, 16); b += __shfl_xor(b, 16);
    a += __shfl_xor(a, 32); b += __shfl_xor(b, 32);
}
__device__ __forceinline__ float bf2f(unsigned short b) { return __uint_as_float(((unsigned)b) << 16); }
__device__ __forceinline__ f32x4 mfma16(bf16x8 a, bf16x8 b, f32x4 c) { return __builtin_amdgcn_mfma_f32_16x16x32_bf16(a, b, c, 0, 0, 0); }
__device__ __forceinline__ s16x4 tr_read(const LAS unsigned char* p) { return __builtin_bit_cast(s16x4, __builtin_amdgcn_ds_read_tr16_b64_v4i16((LAS v4i16_t*)p)); }
__device__ __forceinline__ bf16x8 mk8(s16x4 lo, s16x4 hi) { return (bf16x8){lo[0], lo[1], lo[2], lo[3], hi[0], hi[1], hi[2], hi[3]}; }
__device__ __forceinline__ bf16x8 pack8(f32x4 a, f32x4 b) { u32x4 w; w.x = cvt_pk_bf16(a[0], a[1]); w.y = cvt_pk_bf16(a[2], a[3]); w.z = cvt_pk_bf16(b[0], b[1]); w.w = cvt_pk_bf16(b[2], b[3]); return __builtin_bit_cast(bf16x8, w); }
__device__ __forceinline__ u32x2 pack4(f32x4 a) { u32x2 w; w.x = cvt_pk_bf16(a[0], a[1]); w.y = cvt_pk_bf16(a[2], a[3]); return w; }
__device__ __forceinline__ f32x4 unpack4(u32x2 w) { return (f32x4){__uint_as_float(w.x << 16), __uint_as_float(w.x & 0xffff0000u), __uint_as_float(w.y << 16), __uint_as_float(w.y & 0xffff0000u)}; }

struct EpiProj {
    static constexpr bool PERM = true, AFTER_DRAIN = false;
    GAS bf16_t* O; const LAS float* rtab;
    __device__ __forceinline__ void operator()(const f32x4 (&acc)[2][2][4][2], const pg8::Unit& u, int ui, int wr, int wc, int fr, int fq) const {
        const int row0 = u.pm * 256 + wr * 64 + fr, col0 = u.pn * 256 + wc * 32 + 8 * fq;
        const bool gl = (u.pn == 6 || u.pn == 7);
        float rsv[2][4];
#pragma unroll
        for (int ai = 0; ai < 2; ++ai)
#pragma unroll
            for (int m = 0; m < 4; ++m) rsv[ai][m] = rtab[ui * 256 + wr * 64 + fr + ai * 128 + m * 16];
#pragma unroll
        for (int ai = 0; ai < 2; ++ai)
#pragma unroll
            for (int m = 0; m < 4; ++m) {
                const float rs = rsv[ai][m];
                GAS bf16_t* rowp = O + (size_t)(row0 + ai * 128 + m * 16) * NPROJ + col0;
#pragma unroll
                for (int bj = 0; bj < 2; ++bj) {
                    f32x4 v0 = acc[ai][bj][m][0] * rs, v1 = acc[ai][bj][m][1] * rs;
                    if (gl) { f32x2 a = gelu_pk((f32x2){v0[0], v0[1]}), b = gelu_pk((f32x2){v0[2], v0[3]}), c = gelu_pk((f32x2){v1[0], v1[1]}), d = gelu_pk((f32x2){v1[2], v1[3]});
                        v0 = (f32x4){a.x, a.y, b.x, b.y}; v1 = (f32x4){c.x, c.y, d.x, d.y}; }
                    u32x4 w; w.x = cvt_pk_bf16(v0[0], v0[1]); w.y = cvt_pk_bf16(v0[2], v0[3]); w.z = cvt_pk_bf16(v1[0], v1[1]); w.w = cvt_pk_bf16(v1[2], v1[3]);
                    *(GAS u32x4*)(rowp + bj * 128) = w;
                }
            }
    }
};
struct EpiSwiGLU {
    static constexpr bool PERM = true, AFTER_DRAIN = false;
    GAS bf16_t* O; const LAS float* rtab;
    __device__ __forceinline__ void operator()(const f32x4 (&acc)[2][2][4][2], const pg8::Unit& u, int ui, int wr, int wc, int fr, int fq) const {
        const int row0 = u.pm * 256 + wr * 64 + fr, col0 = u.pn * 128 + wc * 32 + 8 * fq;
        float rsv[2][4];
#pragma unroll
        for (int ai = 0; ai < 2; ++ai)
#pragma unroll
            for (int m = 0; m < 4; ++m) rsv[ai][m] = rtab[ui * 256 + wr * 64 + fr + ai * 128 + m * 16];
#pragma unroll
        for (int ai = 0; ai < 2; ++ai)
#pragma unroll
            for (int m = 0; m < 4; ++m) {
                const float rs = rsv[ai][m];
                f32x4 h[2];
#pragma unroll
                for (int n = 0; n < 2; ++n) {
                    const f32x4 a = acc[ai][0][m][n] * rs, b = acc[ai][1][m][n] * rs;
#pragma unroll
                    for (int j = 0; j < 4; ++j) h[n][j] = a[j] * b[j] * __builtin_amdgcn_rcpf(1.0f + __expf(-a[j]));
                }
                u32x4 w; w.x = cvt_pk_bf16(h[0][0], h[0][1]); w.y = cvt_pk_bf16(h[0][2], h[0][3]); w.z = cvt_pk_bf16(h[1][0], h[1][1]); w.w = cvt_pk_bf16(h[1][2], h[1][3]);
                *(GAS u32x4*)(O + (size_t)(row0 + ai * 128 + m * 16) * DFF + col0) = w;
            }
    }
};
struct EpiResid {
    static constexpr bool PERM = true, AFTER_DRAIN = false;
    GAS bf16_t* xb; GAS float* ssq;
    __device__ __forceinline__ void operator()(const f32x4 (&acc)[2][2][4][2], const pg8::Unit& u, int ui, int wr, int wc, int fr, int fq) const {
        const int row0 = u.pm * 256 + wr * 64 + fr, col0 = u.pn * 256 + wc * 32 + 8 * fq;
#pragma unroll
        for (int ai = 0; ai < 2; ++ai) {
            u32x4 w[4][2];
#pragma unroll
            for (int m = 0; m < 4; ++m)
#pragma unroll
                for (int bj = 0; bj < 2; ++bj) w[m][bj] = *(const GAS u32x4*)(xb + (size_t)(row0 + ai * 128 + m * 16) * D + col0 + bj * 128);
#pragma unroll
            for (int m = 0; m < 4; ++m) {
                const int row = row0 + ai * 128 + m * 16; const size_t off = (size_t)row * D + col0; float q = 0.f;
#pragma unroll
                for (int bj = 0; bj < 2; ++bj) {
                    const f32x4 o0 = unpack4((u32x2){w[m][bj].x, w[m][bj].y}) + acc[ai][bj][m][0], o1 = unpack4((u32x2){w[m][bj].z, w[m][bj].w}) + acc[ai][bj][m][1];
                    *(GAS bf16x8*)(xb + off + bj * 128) = pack8(o0, o1);
                    q += ((o0[0] * o0[0] + o0[1] * o0[1]) + (o0[2] * o0[2] + o0[3] * o0[3])) + ((o1[0] * o1[0] + o1[1] * o1[1]) + (o1[2] * o1[2] + o1[3] * o1[3]));
                }
                q += __shfl_xor(q, 16); q += __shfl_xor(q, 32);
                if (fq == 0) ssq[(size_t)(u.pn * 4 + wc) * M + row] = q;
            }
            asm volatile("" ::: "memory");
        }
    }
};

__device__ __forceinline__ void build_rtab(LAS float* rtab, const pg8::StaticOrder& S, const GAS float* ssq, int tid) {
    float p[3][16]; bool ok[3];
#pragma unroll
    for (int k = 0; k < 3; ++k) { const int idx = tid + 512 * k; pg8::Unit u; ok[k] = S.next(idx >> 8, u);
        if (ok[k]) { const int row = u.pm * 256 + (idx & 255);
#pragma unroll
            for (int j = 0; j < 16; ++j) p[k][j] = ssq[(size_t)j * M + row]; } }
#pragma unroll
    for (int k = 0; k < 3; ++k) if (ok[k]) { float s = 0.f;
#pragma unroll
        for (int j = 0; j < 16; ++j) s += p[k][j];
        rtab[tid + 512 * k] = rsqrtf(s * (1.0f / D) + EPS); }
    for (int idx = tid + 1536; idx < 16 * 256; idx += 512) {
        pg8::Unit u; if (!S.next(idx >> 8, u)) break;
        const int row = u.pm * 256 + (idx & 255); float s = 0.f;
#pragma unroll
        for (int j = 0; j < 16; ++j) s += ssq[(size_t)j * M + row];
        rtab[idx] = rsqrtf(s * (1.0f / D) + EPS);
    }
    __syncthreads();
}

constexpr int TS = 136;
__device__ __forceinline__ void transpose_item(const GAS float* W, int N, int K, int srccol0, float cscale, const GAS float* gk, GAS bf16_t* WT, int drow0, int k0, LAS unsigned char* scr, int lane) {
    const int g4 = lane >> 4, i16 = lane & 15;
    if (srccol0 < 0) {
        const u32x4 z = (u32x4){0u, 0u, 0u, 0u};
#pragma unroll
        for (int nb = 0; nb < 4; ++nb) { GAS bf16_t* o = WT + (size_t)(drow0 + nb * 16 + i16) * K + k0 + 16 * g4; *(GAS u32x4*)o = z; *(GAS u32x4*)(o + 8) = z; }
        return;
    }
    f32x4 v[16];
#pragma unroll
    for (int it = 0; it < 16; ++it) v[it] = *(const GAS f32x4*)(W + (size_t)(k0 + 4 * it + g4) * N + srccol0 + 4 * i16);
#pragma unroll
    for (int it = 0; it < 16; ++it) { const float sc = gk ? gk[k0 + 4 * it + g4] * cscale : cscale;
        *(LAS u32x2*)(scr + (4 * it + g4) * TS + i16 * 8) = pack4(v[it] * sc); }
    asm volatile("s_waitcnt lgkmcnt(0)" ::: "memory");
#pragma unroll
    for (int nb = 0; nb < 4; ++nb) {
        const LAS unsigned char* p = scr + (16 * g4 + (i16 >> 2)) * TS + (nb * 16 + 4 * (i16 & 3)) * 2;
        const s16x4 r0 = tr_read(p), r1 = tr_read(p + 4 * TS), r2 = tr_read(p + 8 * TS), r3 = tr_read(p + 12 * TS);
        GAS bf16_t* o = WT + (size_t)(drow0 + nb * 16 + i16) * K + k0 + 16 * g4;
        *(GAS bf16x8*)o = mk8(r0, r1); *(GAS bf16x8*)(o + 8) = mk8(r2, r3);
    }
    asm volatile("s_waitcnt lgkmcnt(0)" ::: "memory");
}

__device__ __forceinline__ void convert_layer_items(const GAS float* n1g, const GAS float* win, const GAS float* wout, const GAS float* n2g, const GAS float* wfi, const GAS float* wfo, GAS unsigned char* ws, int l, int first, int stride, LAS unsigned char* scr, int lane, int lo = 0, int hi = CONV_IL) {
    constexpr int I1 = 16 * 44, I2 = 16 * 16, I3 = 16 * 88, I4 = 44 * 16;
    for (int it = lo + first; it < hi; it += stride) {
        int r = it;
        if (r < I1) { const int kb = r / 44, nb = r % 44, n0 = 64 * nb;
            const float cs = ((n0 >= C_KR && n0 < C_VR) || (n0 >= C_QA && n0 < C_KA)) ? 0.125f : 1.0f;
            transpose_item(win + (size_t)l * D * NIN, NIN, D, n0 < NIN ? n0 : -1, cs, n1g + l * D, (GAS bf16_t*)(ws + WS_W1) + (size_t)l * NPROJ * D, n0, 64 * kb, scr, lane); continue; }
        r -= I1;
        if (r < I2) { const int kb = r / 16, nb = r % 16;
            transpose_item(wout + (size_t)l * D * D, D, D, 64 * nb, 1.0f, nullptr, (GAS bf16_t*)(ws + WS_W2) + (size_t)l * D * D, 64 * nb, 64 * kb, scr, lane); continue; }
        r -= I2;
        if (r < I3) { const int kb = r / 88, nb = r % 88, n0 = 64 * nb, pn = n0 >> 8, bj = (n0 >> 7) & 1, j = n0 & 127;
            transpose_item(wfi + (size_t)l * D * 2 * DFF, 2 * DFF, D, bj * DFF + 128 * pn + j, 1.0f, n2g + l * D, (GAS bf16_t*)(ws + WS_W3) + (size_t)l * 2 * DFF * D, n0, 64 * kb, scr, lane); continue; }
        r -= I3;
        { const int kb = r / 16, nb = r % 16;
            transpose_item(wfo + (size_t)l * DFF * D, D, DFF, 64 * nb, 1.0f, nullptr, (GAS bf16_t*)(ws + WS_W4) + (size_t)l * D * DFF, 64 * nb, 64 * kb, scr, lane); }
    }
}

__device__ __forceinline__ void prologue(const Args& a, LAS unsigned char* lds, int tid) {
    const int lane = tid & 63, wave = tid >> 6, G = gridDim.x;
    const int gw = blockIdx.x * 8 + wave, NGW = G * 8;
    GAS unsigned char* ws = (GAS unsigned char*)a.ws;
    convert_layer_items((const GAS float*)a.in[1], (const GAS float*)a.in[2], (const GAS float*)a.in[9], (const GAS float*)a.in[10], (const GAS float*)a.in[11], (const GAS float*)a.in[12], ws, 0, gw, NGW, lds + wave * 16384, lane, 0, CONV_SPLIT);
    { const GAS float* wsp = (const GAS float*)a.in[6]; GAS bf16_t* o = (GAS bf16_t*)(ws + WS_WSP);
      for (int i = blockIdx.x * 512 + tid; i < NL * 4 * 128 * 128 / 2; i += G * 512) { const int e = 2 * i, jj = e & 127, ii = (e >> 7) & 127;
          const float w0 = jj <= ii ? wsp[e] : 0.f, w1 = (jj + 1) <= ii ? wsp[e + 1] : 0.f; ((GAS unsigned*)o)[i] = cvt_pk_bf16(w0, w1); } }
    { const GAS float* x = (const GAS float*)a.in[0]; GAS bf16_t* xb = (GAS bf16_t*)(ws + WS_XB); GAS float* ssq = (GAS float*)(ws + WS_SSQ);
      for (int row0 = gw; row0 < M; row0 += 4 * NGW) {
          f32x4 v[4][4]; float s[4];
#pragma unroll
          for (int r = 0; r < 4; ++r) { const int row = row0 + r * NGW; if (row < M) { const GAS f32x4* xr = (const GAS f32x4*)(x + (size_t)row * D);
#pragma unroll
              for (int j = 0; j < 4; ++j) v[r][j] = xr[64 * j + lane]; } }
#pragma unroll
          for (int r = 0; r < 4; ++r) { s[r] = 0.f;
#pragma unroll
              for (int j = 0; j < 4; ++j) s[r] += (v[r][j][0] * v[r][j][0] + v[r][j][1] * v[r][j][1]) + (v[r][j][2] * v[r][j][2] + v[r][j][3] * v[r][j][3]); }
          wave_sum2(s[0], s[1]); wave_sum2(s[2], s[3]);
#pragma unroll
          for (int r = 0; r < 4; ++r) { const int row = row0 + r * NGW; if (row < M) { GAS u32x2* o8 = (GAS u32x2*)(xb + (size_t)row * D);
#pragma unroll
              for (int j = 0; j < 4; ++j) o8[64 * j + lane] = pack4(v[r][j]);
              if (lane < 16) ssq[(size_t)lane * M + row] = (lane == 0) ? s[r] : 0.f; } }
      } }
}
__device__ __forceinline__ void final_norm(GAS float* out, const GAS bf16_t* xb, const GAS float* ssq, const GAS float* gfp, int tid) {
    const int lane = tid & 63, wave = tid >> 6, gw = blockIdx.x * 8 + wave, NGW = gridDim.x * 8;
    f32x4 gf[4];
#pragma unroll
    for (int j = 0; j < 2; ++j) { gf[2 * j] = *(const GAS f32x4*)(gfp + 8 * (64 * j + lane)); gf[2 * j + 1] = *(const GAS f32x4*)(gfp + 8 * (64 * j + lane) + 4); }
    for (int row0 = gw; row0 < M; row0 += 4 * NGW) {
        float s[4]; u32x4 w[4][2];
#pragma unroll
        for (int r = 0; r < 4; ++r) { const int row = row0 + r * NGW; s[r] = 0.f; if (row < M) { s[r] = (lane < 16) ? ssq[(size_t)lane * M + row] : 0.f;
            const GAS u32x4* xr = (const GAS u32x4*)(xb + (size_t)row * D); w[r][0] = xr[lane]; w[r][1] = xr[64 + lane]; } }
        wave_sum2(s[0], s[1]); wave_sum2(s[2], s[3]);
#pragma unroll
        for (int r = 0; r < 4; ++r) { const int row = row0 + r * NGW; if (row < M) { const float rs = rsqrtf(s[r] * (1.0f / D) + EPS); GAS f32x4* orow = (GAS f32x4*)(out + (size_t)row * D);
#pragma unroll
            for (int j = 0; j < 2; ++j) { orow[2 * (64 * j + lane)] = unpack4((u32x2){w[r][j].x, w[r][j].y}) * rs * gf[2 * j]; orow[2 * (64 * j + lane) + 1] = unpack4((u32x2){w[r][j].z, w[r][j].w}) * rs * gf[2 * j + 1]; } } }
    }
}


constexpr int MISC_OFF = 139264;
constexpr int RS = 144;
constexpr int VS = 528;
constexpr size_t WS_TOT = 263 * MiB;

constexpr int WSCR_OFF = 118784, WSCR_STRIDE = 144, WSCR_BYTES = 16 * WSCR_STRIDE;
__device__ __forceinline__ void store_tile16x64(LAS unsigned char* wscr, const u32x2 (&pk)[4], GAS bf16_t* dst  , int lane) {
    const int g4 = lane >> 4, i16 = lane & 15;
#pragma unroll
    for (int et = 0; et < 4; ++et) *(LAS u32x2*)(wscr + i16 * WSCR_STRIDE + et * 32 + g4 * 8) = pk[et];
    asm volatile("s_waitcnt lgkmcnt(0)" ::: "memory");
    u32x4 v[2];
#pragma unroll
    for (int hh = 0; hh < 2; ++hh) v[hh] = *(const LAS u32x4*)(wscr + ((lane >> 3) + 8 * hh) * WSCR_STRIDE + (lane & 7) * 16);
    asm volatile("s_waitcnt lgkmcnt(0)" ::: "memory");
#pragma unroll
    for (int hh = 0; hh < 2; ++hh) *(GAS u32x4*)(dst + (size_t)((lane >> 3) + 8 * hh) * D + (lane & 7) * 8) = v[hh];
}
__device__ __forceinline__ void store_tile16x32(LAS unsigned char* wscr, const u32x2 (&pk)[2], GAS bf16_t* dst, int lane) {
    const int g4 = lane >> 4, i16 = lane & 15;
#pragma unroll
    for (int cc = 0; cc < 2; ++cc) *(LAS u32x2*)(wscr + i16 * WSCR_STRIDE + cc * 32 + g4 * 8) = pk[cc];
    asm volatile("s_waitcnt lgkmcnt(0)" ::: "memory");
    const u32x4 v = *(const LAS u32x4*)(wscr + (lane >> 2) * WSCR_STRIDE + (lane & 3) * 16);
    asm volatile("s_waitcnt lgkmcnt(0)" ::: "memory");
    *(GAS u32x4*)(dst + (size_t)(lane >> 2) * D + (lane & 3) * 8) = v;
}

__device__ __forceinline__ void attn_job(LAS unsigned char* lds, const GAS bf16_t* proj, GAS bf16_t* mixed, const GAS float* sinks, int job, int tid) {
    const int kvh = job & 1, n = (job >> 1) & 31, b = job >> 6;
    const int lane = tid & 63, wid = tid >> 6, g4 = lane >> 4, i16 = lane & 15;
    LAS unsigned char* Kl = lds; LAS unsigned char* Vl = lds + 256 * RS;
    u32x4 kr[4], vr[4];
#pragma unroll
    for (int i = 0; i < 4; ++i) { const int c = tid + 512 * i, row = c >> 3, ch = c & 7;
        kr[i] = (u32x4){0u, 0u, 0u, 0u}; vr[i] = kr[i];
        if (n > 0 || row >= 128) { const GAS bf16_t* p = proj + (size_t)(b * T + n * 128 - 128 + row) * NPROJ; kr[i] = *(const GAS u32x4*)(p + C_KA + kvh * 64 + ch * 8); vr[i] = *(const GAS u32x4*)(p + C_VA + kvh * 64 + ch * 8); } }
    bf16x8 qf[3][2]; float sk[3];
#pragma unroll
    for (int qt = 0; qt < 3; ++qt) { const int t = wid * 3 + qt, g = t >> 3, aa = t & 7, h = kvh * 3 + g; sk[qt] = sinks[h];
        const GAS bf16_t* qp = proj + ((size_t)b * T + n * 128 + 16 * aa + i16) * NPROJ + C_QA + h * 64 + 8 * g4;
        qf[qt][0] = *(const GAS bf16x8*)qp; qf[qt][1] = *(const GAS bf16x8*)(qp + 32); }
#pragma unroll
    for (int i = 0; i < 4; ++i) { const int c = tid + 512 * i, row = c >> 3, ch = c & 7;
        *(LAS u32x4*)(Kl + row * RS + ch * 16) = kr[i]; *(LAS u32x4*)(Vl + row * RS + ch * 16) = vr[i]; }
    lds_barrier();
#pragma unroll 1
    for (int qt = 0; qt < 3; ++qt) {
        const int t = wid * 3 + qt, g = t >> 3, aa = t & 7, h = kvh * 3 + g;
        const float slope = (h == 0) ? 0.25f : (h == 1) ? 0.0625f : (h == 2) ? 0.015625f : (h == 3) ? 0.00390625f : (h == 4) ? 0.5f : 0.125f;
        const float sink = qt == 0 ? sk[0] : (qt == 1 ? sk[1] : sk[2]);
        const int iq = 16 * aa + i16; const size_t tok = (size_t)b * T + n * 128 + iq;
        const bf16x8 q0 = qt == 0 ? qf[0][0] : (qt == 1 ? qf[1][0] : qf[2][0]), q1 = qt == 0 ? qf[0][1] : (qt == 1 ? qf[1][1] : qf[2][1]);
        const int kb0 = aa >> 1;
        f32x4 s[10];
#pragma unroll
        for (int kt = 0; kt < 10; ++kt) { const LAS unsigned char* kp = Kl + ((kb0 * 2 + kt) * 16 + i16) * RS + g4 * 16;
            const bf16x8 k0 = *(const LAS bf16x8*)kp, k1 = *(const LAS bf16x8*)(kp + 64);
            f32x4 z = (f32x4){0.f, 0.f, 0.f, 0.f}; z = mfma16(k0, q0, z); z = mfma16(k1, q1, z); s[kt] = z; }
        float mx = sink;
#pragma unroll
        for (int kt = 0; kt < 10; ++kt)
#pragma unroll
            for (int r = 0; r < 4; ++r) { const int kj = (kb0 * 2 + kt) * 16 + 4 * g4 + r, dist = 128 + iq - kj;
                const bool ok = dist >= 0 && dist < 128 && (n > 0 || kj >= 128);
                const float v = ok ? s[kt][r] - slope * (float)dist : -1e30f; s[kt][r] = v; mx = fmaxf(mx, v); }
        mx = fmaxf(mx, __shfl_xor(mx, 16)); mx = fmaxf(mx, __shfl_xor(mx, 32));
        float sum = 0.f;
#pragma unroll
        for (int kt = 0; kt < 10; ++kt)
#pragma unroll
            for (int r = 0; r < 4; ++r) { const float p = __expf(s[kt][r] - mx); s[kt][r] = p; sum += p; }
        sum += __shfl_xor(sum, 16); sum += __shfl_xor(sum, 32);
        const float inv = 1.0f / (sum + __expf(sink - mx));
        f32x4 o[4];
#pragma unroll
        for (int et = 0; et < 4; ++et) o[et] = (f32x4){0.f, 0.f, 0.f, 0.f};
#pragma unroll
        for (int kb = 0; kb < 5; ++kb) { const bf16x8 pb = pack8(s[2 * kb], s[2 * kb + 1]);
#pragma unroll
            for (int et = 0; et < 4; ++et) { const LAS unsigned char* vp = Vl + ((kb0 + kb) * 32 + 4 * g4 + (i16 >> 2)) * RS + (et * 16 + 4 * (i16 & 3)) * 2;
                o[et] = mfma16(mk8(tr_read(vp), tr_read(vp + 16 * RS)), pb, o[et]); } }
        u32x2 pk[4];
#pragma unroll
        for (int et = 0; et < 4; ++et) pk[et] = pack4(o[et] * inv);
        store_tile16x64(lds + WSCR_OFF + wid * WSCR_BYTES, pk, mixed + ((size_t)b * T + n * 128 + 16 * aa) * D + MIX_ATT + h * 64, lane);
    }
}

__device__ __forceinline__ void gmlp_job(LAS unsigned char* lds, const GAS bf16_t* proj, GAS bf16_t* mixed, const GAS bf16_t* wsb, const GAS float* bsp, const GAS float* lng, const GAS float* lnb, int job, int tid) {
    const int n = job & 31, b = job >> 5;
    const int lane = tid & 63, wid = tid >> 6, g4 = lane >> 4, i16 = lane & 15;
    const size_t tok0 = (size_t)b * T + n * 128;
    const int ct0 = 2 * wid, grp = wid >> 1;
    const GAS bf16_t* wg = wsb + (size_t)grp * 128 * 128 + (size_t)i16 * 128 + 8 * g4;
    bf16x8 wf[4][8]; u32x2 ur[8][2]; float bsv[8];
    { const f32x4 gg = *(const GAS f32x4*)(lng + 4 * lane), bb = *(const GAS f32x4*)(lnb + 4 * lane);
      u32x2 xr[16];
#pragma unroll
      for (int rr = 0; rr < 16; ++rr) xr[rr] = *(const GAS u32x2*)(proj + (tok0 + 16 * wid + rr) * NPROJ + C_V + 4 * lane);
#pragma unroll
      for (int kb = 0; kb < 4; ++kb)
#pragma unroll
          for (int aa = 2 * kb; aa < 8; ++aa) wf[kb][aa] = *(const GAS bf16x8*)(wg + (size_t)(16 * aa) * 128 + 32 * kb);
#pragma unroll
      for (int aa = 0; aa < 8; ++aa) { bsv[aa] = bsp[grp * 128 + 16 * aa + i16];
#pragma unroll
          for (int cc = 0; cc < 2; ++cc) ur[aa][cc] = *(const GAS u32x2*)(proj + (tok0 + 16 * aa + i16) * NPROJ + C_U + (ct0 + cc) * 16 + 4 * g4); }
#pragma unroll
      for (int rr = 0; rr < 16; ++rr) { const int row = 16 * wid + rr;
          const f32x4 x = unpack4(xr[rr]);
          float s1 = (x[0] + x[1]) + (x[2] + x[3]), s2 = (x[0] * x[0] + x[1] * x[1]) + (x[2] * x[2] + x[3] * x[3]);
          wave_sum2(s1, s2);
          const float mu = s1 * (1.0f / 256.0f);
          const f32x4 d = x - mu;
          const float var = fmaxf(s2 * (1.0f / 256.0f) - mu * mu, 0.f);
          const float rs = rsqrtf(var + EPS);
          *(LAS u32x2*)(lds + row * VS + lane * 8) = pack4(d * rs * gg + bb); } }
    lds_barrier();
    f32x4 acc[8][2];
#pragma unroll
    for (int aa = 0; aa < 8; ++aa) { acc[aa][0] = (f32x4){0.f, 0.f, 0.f, 0.f}; acc[aa][1] = acc[aa][0]; }
#pragma unroll
    for (int kb = 0; kb < 4; ++kb) {
        bf16x8 af[2];
#pragma unroll
        for (int cc = 0; cc < 2; ++cc) { const LAS unsigned char* vp = lds + (32 * kb + 8 * g4 + (i16 >> 2)) * VS + ((ct0 + cc) * 16 + 4 * (i16 & 3)) * 2; af[cc] = mk8(tr_read(vp), tr_read(vp + 4 * VS)); }
#pragma unroll
        for (int aa = 2 * kb; aa < 8; ++aa)
#pragma unroll
            for (int cc = 0; cc < 2; ++cc) acc[aa][cc] = mfma16(af[cc], wf[kb][aa], acc[aa][cc]);
    }
#pragma unroll
    for (int aa = 0; aa < 8; ++aa) {
        u32x2 pk[2];
#pragma unroll
        for (int cc = 0; cc < 2; ++cc) pk[cc] = pack4(unpack4(ur[aa][cc]) * (acc[aa][cc] + bsv[aa]));
        store_tile16x32(lds + WSCR_OFF + wid * WSCR_BYTES, pk, mixed + (tok0 + 16 * aa) * D + MIX_MLP + ct0 * 16, lane);
    }
}

__device__ __forceinline__ void kvoct_job(LAS unsigned char* lds, const GAS bf16_t* proj, GAS float* Pb, GAS float* Tot, int job, int tid) {
    const int o = job & 3, h = (job >> 2) % 6, b = job / 24;
    const int lane = tid & 63, wid = tid >> 6, g4 = lane >> 4, i16 = lane & 15;
    const float lg2 = log2f(1.0f - exp2f(-5.0f - (float)h)), cd = exp2f(lg2 * 128.0f);
    const int et = wid >> 1, dt0 = (wid & 1) * 2;
    const int row0 = tid >> 3, ch = tid & 7;
    const float tl0 = exp2f(lg2 * (float)(127 - row0)), tl1 = exp2f(lg2 * (float)(63 - row0));
    const GAS bf16_t* src = proj + ((size_t)b * T + (size_t)(8 * o) * 128 + row0) * NPROJ + h * 64 + ch * 8;
    u32x4 kk[4][2], vv[4][2];
#pragma unroll
    for (int s = 0; s < 4; ++s) { const GAS bf16_t* s2 = src + (size_t)s * 128 * NPROJ;
        kk[s][0] = *(const GAS u32x4*)(s2 + C_KR); vv[s][0] = *(const GAS u32x4*)(s2 + C_VR); kk[s][1] = *(const GAS u32x4*)(s2 + (size_t)64 * NPROJ + C_KR); vv[s][1] = *(const GAS u32x4*)(s2 + (size_t)64 * NPROJ + C_VR); }
    f32x4 P[2]; P[0] = (f32x4){0.f, 0.f, 0.f, 0.f}; P[1] = P[0];
    GAS float* po = Pb + ((size_t)((b * 6 + h) * 32 + 8 * o)) * 4096 + (et * 16 + i16) * 64 + dt0 * 16 + 4 * g4;
#pragma unroll
    for (int c = 0; c < 8; ++c) {
        const int s = c & 3;
        LAS unsigned char* Kl = lds + (c & 1) * (256 * RS); LAS unsigned char* Vl = Kl + 128 * RS;
        *(LAS bf16x8*)(Kl + row0 * RS + ch * 16) = pack8(unpack4((u32x2){kk[s][0].x, kk[s][0].y}) * tl0, unpack4((u32x2){kk[s][0].z, kk[s][0].w}) * tl0);
        *(LAS bf16x8*)(Kl + (row0 + 64) * RS + ch * 16) = pack8(unpack4((u32x2){kk[s][1].x, kk[s][1].y}) * tl1, unpack4((u32x2){kk[s][1].z, kk[s][1].w}) * tl1);
        *(LAS u32x4*)(Vl + row0 * RS + ch * 16) = vv[s][0]; *(LAS u32x4*)(Vl + (row0 + 64) * RS + ch * 16) = vv[s][1];
        if (c + 4 < 8) { const GAS bf16_t* s2 = src + (size_t)(c + 4) * 128 * NPROJ;
            kk[s][0] = *(const GAS u32x4*)(s2 + C_KR); vv[s][0] = *(const GAS u32x4*)(s2 + C_VR); kk[s][1] = *(const GAS u32x4*)(s2 + (size_t)64 * NPROJ + C_KR); vv[s][1] = *(const GAS u32x4*)(s2 + (size_t)64 * NPROJ + C_VR); }
        lds_barrier();
        *(GAS f32x4*)(po + (size_t)c * 4096) = P[0]; *(GAS f32x4*)(po + (size_t)c * 4096 + 16) = P[1];
        f32x4 acc[2]; acc[0] = (f32x4){0.f, 0.f, 0.f, 0.f}; acc[1] = acc[0];
#pragma unroll
        for (int ks = 0; ks < 4; ++ks) {
            const int rowb = 32 * ks + 8 * g4 + (i16 >> 2);
            const LAS unsigned char* vp = Vl + rowb * RS + (et * 16 + 4 * (i16 & 3)) * 2;
            const bf16x8 vf = mk8(tr_read(vp), tr_read(vp + 4 * RS));
#pragma unroll
            for (int dd = 0; dd < 2; ++dd) { const LAS unsigned char* kp = Kl + rowb * RS + ((dt0 + dd) * 16 + 4 * (i16 & 3)) * 2;
                acc[dd] = mfma16(mk8(tr_read(kp), tr_read(kp + 4 * RS)), vf, acc[dd]); }
        }
        P[0] = P[0] * cd + acc[0]; P[1] = P[1] * cd + acc[1];
    }
    GAS float* to = Tot + ((size_t)((b * 6 + h) * 4 + o)) * 4096 + (et * 16 + i16) * 64 + dt0 * 16 + 4 * g4;
    *(GAS f32x4*)to = P[0]; *(GAS f32x4*)(to + 16) = P[1];
}

struct RetRegs { u32x4 k0, k1, v0, v1; f32x4 s0, s1, t0[3], t1[3]; bf16x8 q0, q1; u32x2 gtr[4]; f32x4 rg[4]; };
constexpr int RET_BUF = 320 * RS;
__device__ __forceinline__ void ret_load(RetRegs& R, const GAS bf16_t* proj, const GAS float* Pb, const GAS float* Tot, const GAS float* retg, int job, int tid) {
    const int n = job & 31, h = (job >> 5) % 6, b = job / 192;
    const int lane = tid & 63, wid = tid >> 6, g4 = lane >> 4, i16 = lane & 15;
    const size_t tok0 = (size_t)b * T + n * 128, tok = tok0 + 16 * wid + i16;
    const int row0 = tid >> 3, ch = tid & 7;
    const GAS bf16_t* src = proj + (tok0 + row0) * NPROJ + h * 64 + ch * 8;
    R.k0 = *(const GAS u32x4*)(src + C_KR); R.v0 = *(const GAS u32x4*)(src + C_VR); R.k1 = *(const GAS u32x4*)(src + (size_t)64 * NPROJ + C_KR); R.v1 = *(const GAS u32x4*)(src + (size_t)64 * NPROJ + C_VR);
    const int oc = n >> 3;
    const GAS float* pp = Pb + ((size_t)((b * 6 + h) * 32 + n)) * 4096 + tid * 8;
    R.s0 = *(const GAS f32x4*)pp; R.s1 = *(const GAS f32x4*)(pp + 4);
#pragma unroll
    for (int oo = 0; oo < 3; ++oo) { const int os = oo < oc ? oo : 0; const GAS float* tp = Tot + ((size_t)((b * 6 + h) * 4 + os)) * 4096 + tid * 8;
        R.t0[oo] = *(const GAS f32x4*)tp; R.t1[oo] = *(const GAS f32x4*)(tp + 4); }
    const GAS bf16_t* qp = proj + tok * NPROJ + C_QR + h * 64 + 8 * g4;
    R.q0 = *(const GAS bf16x8*)qp; R.q1 = *(const GAS bf16x8*)(qp + 32);
#pragma unroll
    for (int et = 0; et < 4; ++et) { const int c = h * 64 + et * 16 + 4 * g4; R.gtr[et] = *(const GAS u32x2*)(proj + tok * NPROJ + C_GR + c); R.rg[et] = *(const GAS f32x4*)(retg + c); }
}
__device__ __forceinline__ void ret_stage(const RetRegs& R, LAS unsigned char* buf, int job, int tid) {
    const int n = job & 31, h = (job >> 5) % 6, oc = n >> 3;
    const float lg2 = log2f(1.0f - exp2f(-5.0f - (float)h));
    LAS unsigned char* Kl = buf; LAS unsigned char* Vl = buf + 128 * RS; LAS unsigned char* Sl = buf + 256 * RS;
    const int row0 = tid >> 3, ch = tid & 7;
    *(LAS u32x4*)(Kl + row0 * RS + ch * 16) = R.k0; *(LAS u32x4*)(Kl + (row0 + 64) * RS + ch * 16) = R.k1;
    *(LAS u32x4*)(Vl + row0 * RS + ch * 16) = R.v0; *(LAS u32x4*)(Vl + (row0 + 64) * RS + ch * 16) = R.v1;
    f32x4 s0 = R.s0, s1 = R.s1;
#pragma unroll
    for (int oo = 0; oo < 3; ++oo) { const float tf = oo < oc ? exp2f(lg2 * 128.0f * (float)(n - 8 * (oo + 1))) : 0.f; s0 = s0 + R.t0[oo] * tf; s1 = s1 + R.t1[oo] * tf; }
    *(LAS bf16x8*)(Sl + (tid >> 3) * RS + (tid & 7) * 16) = pack8(s0, s1);
}
__device__ __forceinline__ void ret_compute(const RetRegs& R, const LAS unsigned char* buf, LAS unsigned char* wscr, GAS bf16_t* mixed, int job, int tid) {
    const int n = job & 31, h = (job >> 5) % 6, b = job / 192;
    const int lane = tid & 63, wid = tid >> 6, g4 = lane >> 4, i16 = lane & 15;
    const float lg2 = log2f(1.0f - exp2f(-5.0f - (float)h));
    const LAS unsigned char* Kl = buf; const LAS unsigned char* Vl = buf + 128 * RS; const LAS unsigned char* Sl = buf + 256 * RS;
    const int aa = wid, iq = 16 * aa + i16; const size_t tok = (size_t)b * T + n * 128 + iq;
    const bf16x8 q0 = R.q0, q1 = R.q1;
    f32x4 o[4];
#pragma unroll
    for (int et = 0; et < 4; ++et) o[et] = (f32x4){0.f, 0.f, 0.f, 0.f};
    f32x4 s[4][2];
#pragma unroll
    for (int kb = 0; kb < 4; ++kb)
#pragma unroll
        for (int tt = 0; tt < 2; ++tt) { const LAS unsigned char* kp = Kl + ((2 * kb + tt) * 16 + i16) * RS + g4 * 16;
            const bf16x8 ka = *(const LAS bf16x8*)kp, kb2 = *(const LAS bf16x8*)(kp + 64);
            f32x4 z = (f32x4){0.f, 0.f, 0.f, 0.f}; z = mfma16(ka, q0, z); z = mfma16(kb2, q1, z); s[kb][tt] = z; }
#pragma unroll
    for (int kb = 0; kb < 4; ++kb)
#pragma unroll
        for (int tt = 0; tt < 2; ++tt)
#pragma unroll
            for (int r = 0; r < 4; ++r) { const int dl = iq - ((2 * kb + tt) * 16 + 4 * g4 + r); s[kb][tt][r] = dl >= 0 ? s[kb][tt][r] * __builtin_amdgcn_exp2f(lg2 * (float)dl) : 0.f; }
#pragma unroll
    for (int kb = 0; kb < 4; ++kb) {
        const bf16x8 pb = pack8(s[kb][0], s[kb][1]);
#pragma unroll
        for (int et = 0; et < 4; ++et) { const LAS unsigned char* vp = Vl + (kb * 32 + 4 * g4 + (i16 >> 2)) * RS + (et * 16 + 4 * (i16 & 3)) * 2;
            o[et] = mfma16(mk8(tr_read(vp), tr_read(vp + 16 * RS)), pb, o[et]); }
    }
    { const float hd = exp2f(lg2 * (float)(iq + 1));
#pragma unroll
      for (int et = 0; et < 4; ++et) { const LAS unsigned char* sp = Sl + (et * 16 + i16) * RS + g4 * 16;
          f32x4 z = (f32x4){0.f, 0.f, 0.f, 0.f}; z = mfma16(*(const LAS bf16x8*)sp, q0, z); z = mfma16(*(const LAS bf16x8*)(sp + 64), q1, z);
          o[et] = o[et] + z * hd; } }
    float ss = 0.f;
#pragma unroll
    for (int et = 0; et < 4; ++et) ss += (o[et][0] * o[et][0] + o[et][1] * o[et][1]) + (o[et][2] * o[et][2] + o[et][3] * o[et][3]);
    ss += __shfl_xor(ss, 16); ss += __shfl_xor(ss, 32);
    const float rinv = rsqrtf(ss * (1.0f / 64.0f) + EPS);
    u32x2 pk[4];
#pragma unroll
    for (int et = 0; et < 4; ++et) {
        const f32x4 gt = unpack4(R.gtr[et]);
        f32x4 y;
#pragma unroll
        for (int r = 0; r < 4; ++r) y[r] = o[et][r] * rinv * R.rg[et][r] * gt[r] * __builtin_amdgcn_rcpf(1.0f + __expf(-gt[r]));
        pk[et] = pack4(y); }
    store_tile16x64(wscr, pk, mixed + ((size_t)b * T + n * 128 + 16 * aa) * D + MIX_RET + h * 64, lane);
}

#define RLX_AGENT __ATOMIC_RELAXED, __HIP_MEMORY_SCOPE_AGENT
#define XB_TMO      128
#define XB_XCNT(j)  (256  + 64 * (j))
#define XB_XSUB(j)  (1280 + 64 * (j))
#define XB_XGEN(j)  (2304 + 64 * (j))
#define XB_TOP      3328
#define XB_TOPGEN   3392
#define XCD_BAR_WORDS 3456
#define XB_SPIN_CAP (1u << 18)

__device__ __forceinline__ unsigned xb_ld(unsigned* p)              { return __hip_atomic_load(p, __ATOMIC_RELAXED, __HIP_MEMORY_SCOPE_AGENT); }
__device__ __forceinline__ unsigned xb_add(unsigned* p, unsigned v) { return __hip_atomic_fetch_add(p, v, __ATOMIC_RELAXED, __HIP_MEMORY_SCOPE_AGENT); }
__device__ __forceinline__ unsigned xb_xcc_id() { return (unsigned)__builtin_amdgcn_s_getreg((3 << 11) | 20) & 0xFu; }
#define XB_SPIN(cond, bar) do { unsigned _sp = 0; while (cond) { __builtin_amdgcn_s_sleep(1); \
    if ((++_sp & 255u) == 0u) { if (xb_ld(&(bar)[XB_TMO])) break; if (_sp > XB_SPIN_CAP) { atomicAdd(&(bar)[XB_TMO], 1u); break; } } } } while (0)

struct XcdBarrier {
    unsigned* bar; unsigned x;
    volatile LAS unsigned* st;
};

__device__ __forceinline__ XcdBarrier xcd_barrier_post(unsigned* bar, volatile LAS unsigned* st) {
    XcdBarrier b; b.bar = bar; b.x = xb_xcc_id(); b.st = st;
    if (threadIdx.x == 0) (void)xb_add(&bar[XB_XCNT(b.x)], 1u);
    return b;
}
__device__ __forceinline__ void xcd_barrier_complete(unsigned* bar, unsigned x, unsigned& nloc, unsigned& nx) {
    const unsigned G = gridDim.x * gridDim.y * gridDim.z;
    unsigned sum, cnt, mine, sp = 0u;
    for (;;) {
        sum = 0u; cnt = 0u; mine = 0u;
#pragma unroll
        for (unsigned j = 0; j < 16; ++j) { const unsigned c = xb_ld(&bar[XB_XCNT(j)]); sum += c; cnt += (c > 0u) ? 1u : 0u; mine = (j == x) ? c : mine; }
        if (sum == G) break;
        __builtin_amdgcn_s_sleep(1);
        if ((++sp & 255u) == 0u) { if (xb_ld(&bar[XB_TMO])) break; if (sp > XB_SPIN_CAP) { atomicAdd(&bar[XB_TMO], 1u); break; } }
    }
    nloc = mine > 0u ? mine : 1u; nx = cnt > 0u ? cnt : 1u;
}

__device__ __forceinline__ void xcd_barrier(const XcdBarrier& b) {
    asm volatile("s_waitcnt vmcnt(0)" ::: "memory");
    __syncthreads();
    if (threadIdx.x == 0) {
        unsigned* bar = b.bar;
        __builtin_amdgcn_s_waitcnt(0);
        unsigned nloc = b.st[0], nx = b.st[1];
        if (nloc == 0u) { xcd_barrier_complete(bar, b.x, nloc, nx); b.st[0] = nloc; b.st[1] = nx; }
        const unsigned old = xb_add(&bar[XB_XSUB(b.x)], 1u);
        const unsigned gen = old / nloc;
        if (old + 1u == (gen + 1u) * nloc) {
            __builtin_amdgcn_fence(__ATOMIC_RELEASE, "agent");
            asm volatile("s_waitcnt vmcnt(0)" ::: "memory");
            const unsigned og = xb_add(&bar[XB_TOP], 1u);
            const unsigned tg = og / nx;
            if (og + 1u == (tg + 1u) * nx) xb_add(&bar[XB_TOPGEN], 1u);
            else XB_SPIN(xb_ld(&bar[XB_TOPGEN]) == tg, bar);
            __builtin_amdgcn_fence(__ATOMIC_ACQUIRE, "agent");
            xb_add(&bar[XB_XGEN(b.x)], 1u);
            asm volatile("s_waitcnt vmcnt(0)" ::: "memory");
        } else {
            XB_SPIN(xb_ld(&bar[XB_TOPGEN]) == gen, bar);
            __builtin_amdgcn_fence(__ATOMIC_ACQUIRE, "agent");
            asm volatile("s_waitcnt vmcnt(0)" ::: "memory");
        }
    }
    __syncthreads();
}

constexpr size_t WS_BAR = 65536;
__device__ __forceinline__ GAS unsigned char* launder_ptr(unsigned char* p) {
    unsigned lo = (unsigned)(unsigned long long)p, hi = (unsigned)((unsigned long long)p >> 32); asm volatile("" : "+v"(lo), "+v"(hi));
    lo = __builtin_amdgcn_readfirstlane(lo); hi = __builtin_amdgcn_readfirstlane(hi); return (GAS unsigned char*)(((unsigned long long)hi << 32) | lo);
}
__device__ __forceinline__ int retjob(int bb, int idx, int nhalf, int k) { const int q = idx * 3 + k; return bb * 192 + (q >> 4) * 32 + nhalf + (q & 15); }
__device__ __forceinline__ void kv_wait(unsigned* kvc, int tid) {
    if (tid == 0) { unsigned sp = 0; while (__hip_atomic_load(kvc, __ATOMIC_RELAXED, __HIP_MEMORY_SCOPE_AGENT) < 96u) { __builtin_amdgcn_s_sleep(2); if (++sp > (1u << 22)) break; }
        __builtin_amdgcn_fence(__ATOMIC_ACQUIRE, "agent"); asm volatile("s_waitcnt vmcnt(0)" ::: "memory"); }
    lds_barrier();
}
#define PH(k, ...) do { int tid = threadIdx.x; asm volatile("" : "+v"(tid)); int bid_ = blockIdx.x; asm volatile("" : "+v"(bid_)); const int bid = __builtin_amdgcn_readfirstlane(bid_); (void)bid; \
    GAS unsigned char* ws = launder_ptr(a.ws); __VA_ARGS__ } while (0)
#define GSYNC() xcd_barrier(bar)
#define PTAB(i) ((const GAS float*)(((const GAS unsigned long long*)ws)[i]))
__global__ void __launch_bounds__(512, 2) fwd_mega(Args a) {
    extern __shared__ __attribute__((aligned(16))) unsigned char lds_raw[];
    LAS unsigned char* lds = (LAS unsigned char*)lds_raw;
    cg::grid_group grid = cg::this_grid();
    if (a.ws == nullptr) grid.sync();
    { volatile LAS unsigned* misc = (volatile LAS unsigned*)(lds + MISC_OFF); if (threadIdx.x < 32) misc[threadIdx.x] = 0u; __syncthreads(); }
    const XcdBarrier bar = xcd_barrier_post((unsigned*)(a.ws + WS_BAR), (volatile LAS unsigned*)(lds + MISC_OFF + 32));
    PH(6, { prologue(a, lds, tid); if (blockIdx.x == 0 && tid == 0) { _Pragma("unroll") for (int i_ = 0; i_ < 14; ++i_) ((GAS unsigned long long*)ws)[i_] = (unsigned long long)a.in[i_]; } });
    GSYNC();
#pragma unroll 1
    for (int l = 0; l < NL; ++l) {
        PH(0, {
            pg8::Gemm g{(const bf16_t*)(ws + WS_XB), (const bf16_t*)(ws + WS_W1) + (size_t)l * NPROJ * D, M, NPROJ, D}; pg8::StaticOrder S; S.init(M, NPROJ, (int)gridDim.x, bid);
            LAS float* rtab = (LAS float*)(lds + RTAB_OFF);
            build_rtab(rtab, S, (const GAS float*)(ws + WS_SSQ), tid);
            EpiProj E{(GAS bf16_t*)(ws + WS_PROJ), rtab};
            pg8::gemm_phase<EpiProj, pg8::StaticOrder, true, true>(lds, g, S, E);
            if (l == 0 && bid >= 192)
                convert_layer_items(PTAB(1), PTAB(2), PTAB(9), PTAB(10), PTAB(11), PTAB(12), ws, 0, (bid - 192) * 8 + (tid >> 6), ((int)gridDim.x - 192) * 8, lds + (tid >> 6) * 16384, tid & 63, CONV_SPLIT, CONV_IL); });
        GSYNC();
        PH(1, {
            const GAS bf16_t* PROJ = (const GAS bf16_t*)(ws + WS_PROJ); GAS bf16_t* MIX = (GAS bf16_t*)(ws + WS_MIX);
            unsigned* kvcnt = (unsigned*)(ws + WS_BAR) + 4096 + 64 * l;
            const int c = bid;
            if (gridDim.x == 256) {
                unsigned* kvc = kvcnt;
                const GAS float* Pb = (const GAS float*)(ws + WS_KV); const GAS float* Tot = (const GAS float*)(ws + WS_TOT); const GAS float* retg = PTAB(3) + l * 384;
                const int xcd = c & 7, idx = c >> 3, bb = xcd >> 1, nhalf = (xcd & 1) * 16;
                const int nj = 3;
                if (c < 96) {
                    kvoct_job(lds, PROJ, (GAS float*)(ws + WS_KV), (GAS float*)(ws + WS_TOT), bb * 24 + (idx % 6) * 4 + (xcd & 1) * 2 + idx / 6, tid);
                    asm volatile("s_waitcnt vmcnt(0)" ::: "memory"); lds_barrier();
                    if (tid == 0) { __builtin_amdgcn_fence(__ATOMIC_RELEASE, "agent"); asm volatile("s_waitcnt vmcnt(0)" ::: "memory"); __hip_atomic_fetch_add(kvc, 1u, __ATOMIC_RELAXED, __HIP_MEMORY_SCOPE_AGENT); }
                } else if (c < 224) gmlp_job(lds, PROJ, MIX, (const GAS bf16_t*)(ws + WS_WSP) + (size_t)l * 4 * 128 * 128, PTAB(7) + l * 512, PTAB(4) + l * 256, PTAB(5) + l * 256, (bb << 5) | (nhalf + idx - 12), tid);
                lds_barrier();
                attn_job(lds, PROJ, MIX, PTAB(8) + l * 6, (bb << 6) | ((nhalf + (idx >> 1)) << 1) | (idx & 1), tid);
                kv_wait(kvc, tid);
                RetRegs cur;
                ret_load(cur, PROJ, Pb, Tot, retg, retjob(bb, idx, nhalf, 0), tid);
                lds_barrier();
                _Pragma("unroll 1") for (int k = 0; k < nj; ++k) {
                    LAS unsigned char* buf = lds + (k & 1) * RET_BUF;
                    ret_stage(cur, buf, retjob(bb, idx, nhalf, k), tid);
                    lds_barrier();
                    RetRegs nxt; ret_load(nxt, PROJ, Pb, Tot, retg, retjob(bb, idx, nhalf, k + 1 < nj ? k + 1 : k), tid);
                    ret_compute(cur, buf, lds + WSCR_OFF + (tid >> 6) * WSCR_BYTES, MIX, retjob(bb, idx, nhalf, k), tid);
                    cur = nxt;
                }
            } });
        GSYNC();
        PH(3, {
            pg8::Gemm g{(const bf16_t*)(ws + WS_MIX), (const bf16_t*)(ws + WS_W2) + (size_t)l * D * D, M, D, D}; pg8::StaticOrder S; S.init(M, D, (int)gridDim.x, bid);
            EpiResid E{(GAS bf16_t*)(ws + WS_XB), (GAS float*)(ws + WS_SSQ)};
            pg8::gemm_phase<EpiResid, pg8::StaticOrder, true, true>(lds, g, S, E); });
        GSYNC();
        PH(4, {
            pg8::Gemm g{(const bf16_t*)(ws + WS_XB), (const bf16_t*)(ws + WS_W3) + (size_t)l * 2 * DFF * D, M, 2 * DFF, D}; pg8::StaticOrder S; S.init(M, 2 * DFF, (int)gridDim.x, bid);
            LAS float* rtab = (LAS float*)(lds + RTAB_OFF);
            build_rtab(rtab, S, (const GAS float*)(ws + WS_SSQ), tid);
            EpiSwiGLU E{(GAS bf16_t*)(ws + WS_PROJ), rtab};
            pg8::gemm_phase<EpiSwiGLU, pg8::StaticOrder, true, true>(lds, g, S, E);
            if (l + 1 < NL && bid >= CONV_FIRST_WG)
                convert_layer_items(PTAB(1), PTAB(2), PTAB(9), PTAB(10), PTAB(11), PTAB(12), ws, l + 1, (bid - CONV_FIRST_WG) * 8 + (tid >> 6), ((int)gridDim.x - CONV_FIRST_WG) * 8, lds + (tid >> 6) * 16384, tid & 63); });
        GSYNC();
        PH(5, {
            pg8::Gemm g{(const bf16_t*)(ws + WS_PROJ), (const bf16_t*)(ws + WS_W4) + (size_t)l * D * DFF, M, D, DFF}; pg8::StaticOrder S; S.init(M, D, (int)gridDim.x, bid);
            EpiResid E{(GAS bf16_t*)(ws + WS_XB), (GAS float*)(ws + WS_SSQ)};
            pg8::gemm_phase<EpiResid, pg8::StaticOrder, true, true>(lds, g, S, E); });
        GSYNC();
    }
    PH(8, { final_norm((GAS float*)a.out, (const GAS bf16_t*)(ws + WS_XB), (const GAS float*)(ws + WS_SSQ), PTAB(13), tid); });
}

extern "C" void kernel_launch(void* const* d_in, const int* in_sizes, int n_in, void* d_out, int out_size, void* d_ws, size_t ws_size, hipStream_t stream) {
    static int grid = 0;
    if (grid == 0) {
        if (n_in != 14 || out_size != M * D || ws_size < WS_END) { fprintf(stderr, "kernel_launch: unexpected shapes (n_in %d, out %d, ws %zu)\n", n_in, out_size, ws_size); grid = -1; return; }
        int dev = 0, cus = 0, per_cu = 0;
        (void)hipGetDevice(&dev); (void)hipDeviceGetAttribute(&cus, hipDeviceAttributeMultiprocessorCount, dev);
        if (hipFuncSetAttribute((const void*)fwd_mega, hipFuncAttributeMaxDynamicSharedMemorySize, LDS_BYTES) != hipSuccess) { fprintf(stderr, "kernel_launch: hipFuncSetAttribute failed\n"); grid = -1; return; }
        (void)hipOccupancyMaxActiveBlocksPerMultiprocessor(&per_cu, (const void*)fwd_mega, 512, LDS_BYTES);
        (void)hipGetLastError();
        if (per_cu < 1) fprintf(stderr, "kernel_launch: occupancy query says %d blocks/CU\n", per_cu);
        grid = cus;
        if (grid != 256) fprintf(stderr, "kernel_launch: %d CUs (built for 256)\n", grid);
    }
    if (grid < 0) return;
    Args a{};
    for (int i = 0; i < 14; ++i) a.in[i] = (const float*)d_in[i];
    a.out = (float*)d_out; a.ws = (unsigned char*)d_ws;
    if (hipMemsetAsync((unsigned char*)d_ws + WS_BAR, 0, 32768, stream) != hipSuccess) { fprintf(stderr, "kernel_launch: memset of barrier words failed\n"); return; }
    void* args[] = {&a};
    hipError_t e = hipLaunchCooperativeKernel((const void*)fwd_mega, dim3(grid), dim3(512), args, LDS_BYTES, stream);
    if (e != hipSuccess) fprintf(stderr, "kernel_launch: cooperative launch failed: %s (grid %d)\n", hipGetErrorString(e), grid);
}
```

```cpp
#include <hip/hip_runtime.h>
#include <hip/hip_cooperative_groups.h>
#include <cstdio>
#include <cstdint>
namespace cg = cooperative_groups;
namespace pg8 {
#define PG8_LAS __attribute__((address_space(3)))
typedef unsigned short bf16_t;
typedef short bf16x8 __attribute__((ext_vector_type(8)));
typedef float f32x4 __attribute__((ext_vector_type(4)));
typedef unsigned u32x4 __attribute__((ext_vector_type(4)));
constexpr int BM = 256, BK = 64, HALF = 128, HTB = HALF * BK * 2  , STAGE_BYTES = 8 * HTB, NXCD = 8, WGM = 4;

__host__ __device__ __forceinline__ int lds_byte(int r, int c) { const int st = (r >> 4) * 2 + (c >> 5), rr = r & 15, cc = c & 31, ob = rr * 64 + cc * 2; return st * 1024 + (ob ^ (((ob >> 9) & 1) << 5)); }
__host__ __device__ __forceinline__ void stage_rc(int b, int& R, int& C) { const int st = b / 1024, sb = b % 1024, swz = sb ^ (((sb >> 9) & 1) << 5); R = (st >> 1) * 16 + swz / 64; C = (st & 1) * 32 + (swz % 64) / 2; }
__host__ __device__ __forceinline__ int perm32(int rho) { const int n = rho >> 4, i = rho & 15; return 8 * (i >> 2) + 4 * n + (i & 3); }

struct Unit { int pm, pn; };
struct Gemm { const bf16_t* A; const bf16_t* Bt; int M, N, K; };

struct StaticOrder {
    int nM, nN, nwg, G, c;
    __host__ __device__ void init(int M, int N, int G_, int c_) { nM = M / BM; nN = N / BM; nwg = nM * nN; G = G_; c = c_; }
    __host__ __device__ bool next(int i, Unit& u) const {
        const long L = (long)i * G + c; if (L >= nwg) return false;
        int wgid = (int)L; { const int q = nwg / NXCD, r = nwg % NXCD, xcd = wgid % NXCD, off = wgid / NXCD; wgid = (xcd < r ? xcd * (q + 1) : r * (q + 1) + (xcd - r) * q) + off; }
        const int nig = WGM * nN, gid = wgid / nig, fm = gid * WGM, gsz = (nM - fm) < WGM ? (nM - fm) : WGM;
        u.pm = fm + ((wgid % nig) % gsz); u.pn = (wgid % nig) / gsz; return true;
    }
    __device__ __forceinline__ void a_ready(const Unit&) const {}
    __device__ __forceinline__ void done(const Unit&) const {}
};
__device__ __forceinline__ unsigned cvt_pk_bf16(float lo, float hi) { unsigned r; asm volatile("v_cvt_pk_bf16_f32 %0, %1, %2" : "=v"(r) : "v"(lo), "v"(hi)); return r; }
typedef float f32x2 __attribute__((ext_vector_type(2)));
__device__ __forceinline__ f32x2 gelu_pk(f32x2 v) {
    const f32x2 av = __builtin_elementwise_abs(v), d = av * 0.2316418882f + 1.0f;
    f32x2 t; t.x = __builtin_amdgcn_rcpf(d.x); t.y = __builtin_amdgcn_rcpf(d.y);
    f32x2 q = t * 0.5307027145f + (-0.7265760135f); q = q * t + 0.7107068705f; q = q * t + (-0.142248368f); q = q * t + 0.127414796f; q = q * t;
    const f32x2 s = (v * v) * (-0.72134752044f);
    f32x2 e; e.x = __builtin_amdgcn_exp2f(s.x); e.y = __builtin_amdgcn_exp2f(s.y);
    const f32x2 m = v * (q * e), r = v - m;
    f32x2 o; o.x = v.x < 0.f ? m.x : r.x; o.y = v.y < 0.f ? m.y : r.y; return o;
}
template <class Epi, class Sched, bool ALIGN_EPI = false, bool SP2 = false>
__device__ __forceinline__ void gemm_phase(PG8_LAS unsigned char* lds, const Gemm g, const Sched& S, const Epi& E) {
    int tid_ = threadIdx.x; asm volatile("" : "+v"(tid_));
    const int tid = tid_, wid = __builtin_amdgcn_readfirstlane(tid >> 6), lane = tid & 63, wr = wid >> 2, wc = wid & 3, fr = lane & 15, fq = lane >> 4;
    const int K = g.K, nt = K / BK;
    unsigned voffA[2], voffB[2];
#pragma unroll
    for (int i = 0; i < 2; ++i) { int R, C; stage_rc(tid * 16 + i * 8192, R, C); const int Rb = Epi::PERM ? ((R & ~31) + perm32(R & 31)) : R;
        voffA[i] = (unsigned)(R * K + C) * 2u; voffB[i] = (unsigned)(Rb * K + C) * 2u; }
    const size_t kstep = (size_t)(BK * 2);
    const size_t hstep = (size_t)HALF * K * 2;
    const size_t tstep = 2 * hstep;
    const unsigned ldsw = (unsigned)wid * 1024u;
    const int aoff = lds_byte(wr * 64 + fr, fq * 8), boff = lds_byte(wc * 32 + fr, fq * 8);
#define PG8_SA(b, h) (((b) * 2 + (h)) * HTB)
#define PG8_SB(b, h) ((4 + (b) * 2 + (h)) * HTB)
#define PG8_STAGE(bufoff, gbase, voff) do { _Pragma("unroll") for (int _i = 0; _i < 2; ++_i) \
        __builtin_amdgcn_global_load_lds((const unsigned*)((const char*)(gbase) + (voff)[_i]), (PG8_LAS unsigned*)(lds + (bufoff) + ldsw + _i * 8192), 16, 0, 0); } while (0)
#define PG8_LDA(dst, b, h) do { _Pragma("unroll") for (int m = 0; m < 4; ++m) _Pragma("unroll") for (int k = 0; k < 2; ++k) dst[m][k] = *(const PG8_LAS bf16x8*)(lds + PG8_SA(b, h) + aoff + m * 2048 + k * 1024); } while (0)
#define PG8_LDB(dst, b, h) do { _Pragma("unroll") for (int n = 0; n < 2; ++n) _Pragma("unroll") for (int k = 0; k < 2; ++k) dst[n][k] = *(const PG8_LAS bf16x8*)(lds + PG8_SB(b, h) + boff + n * 2048 + k * 1024); } while (0)
#define PG8_MMA(ai, bj, At, Bt) do { __builtin_amdgcn_s_setprio(1); _Pragma("unroll") for (int m = 0; m < 4; ++m) _Pragma("unroll") for (int n = 0; n < 2; ++n) _Pragma("unroll") for (int k = 0; k < 2; ++k) \
        acc[ai][bj][m][n] = __builtin_amdgcn_mfma_f32_16x16x32_bf16(Bt[n][k], At[m][k], acc[ai][bj][m][n], 0, 0, 0); __builtin_amdgcn_s_setprio(0); } while (0)
#define PG8_WAIT_V(n) asm volatile("s_waitcnt vmcnt(" #n ")" ::: "memory")
#define PG8_WAIT_L(n) asm volatile("s_waitcnt lgkmcnt(" #n ")" ::: "memory")
#define PG8_BAR __builtin_amdgcn_s_barrier()
#define PG8_SCHED __builtin_amdgcn_sched_barrier(0)
    Unit cur, nxt; int ui = 0;
    if (!S.next(0, cur)) return;
    f32x4 acc[2][2][4][2];
#pragma unroll
    for (int a = 0; a < 2; ++a)
#pragma unroll
        for (int b = 0; b < 2; ++b)
#pragma unroll
            for (int m = 0; m < 4; ++m)
#pragma unroll
                for (int n = 0; n < 2; ++n) acc[a][b][m][n] = (f32x4){0.f, 0.f, 0.f, 0.f};
    bf16x8 At[4][2], B0[2][2], B1[2][2];
    const char* cA = (const char*)g.A + (size_t)cur.pm * tstep; const char* cB = (const char*)g.Bt + (size_t)cur.pn * tstep;
    S.a_ready(cur);
    if constexpr (SP2) {
        PG8_STAGE(PG8_SB(0, 0), cB, voffB); PG8_STAGE(PG8_SB(0, 1), cB + hstep, voffB); PG8_STAGE(PG8_SA(0, 0), cA, voffA); PG8_STAGE(PG8_SA(0, 1), cA + hstep, voffA);
        if (wr == 1) PG8_BAR;
        PG8_WAIT_V(2); PG8_BAR;
        PG8_STAGE(PG8_SB(1, 0), cB + kstep, voffB); PG8_STAGE(PG8_SA(1, 0), cA + kstep, voffA); PG8_STAGE(PG8_SB(1, 1), cB + hstep + kstep, voffB);
        PG8_WAIT_V(6); PG8_BAR;
    } else {
        PG8_STAGE(PG8_SB(0, 0), cB, voffB); PG8_STAGE(PG8_SA(0, 0), cA, voffA); PG8_STAGE(PG8_SB(0, 1), cB + hstep, voffB); PG8_STAGE(PG8_SA(0, 1), cA + hstep, voffA);
        if (wr == 1) PG8_BAR;
        PG8_WAIT_V(4); PG8_BAR;
        PG8_STAGE(PG8_SB(1, 0), cB + kstep, voffB); PG8_STAGE(PG8_SA(1, 0), cA + kstep, voffA); PG8_STAGE(PG8_SB(1, 1), cB + hstep + kstep, voffB);
        PG8_WAIT_V(6); PG8_BAR;
    }
    for (;;) {
        const bool has_next = S.next(ui + 1, nxt);
        const char* nA = has_next ? (const char*)g.A + (size_t)nxt.pm * tstep : cA; const char* nB = has_next ? (const char*)g.Bt + (size_t)nxt.pn * tstep : cB;
        for (int t = 0; t < nt; t += 2) {
            const bool last = (t == nt - 2);
            const char* a1 = cA + (size_t)(t + 1) * kstep;
            const char* a2 = last ? nA : cA + (size_t)(t + 2) * kstep; const char* b2 = last ? nB : cB + (size_t)(t + 2) * kstep;
            const char* a3 = a2 + kstep; const char* b3 = b2 + kstep;
            if (last && has_next) S.a_ready(nxt);
            if constexpr (SP2) {
            PG8_LDB(B0, 0, 0); PG8_LDB(B1, 0, 1); PG8_SCHED; PG8_LDA(At, 0, 0); PG8_STAGE(PG8_SA(1, 1), a1 + hstep, voffA);
            PG8_WAIT_V(8); PG8_WAIT_L(0); PG8_BAR; PG8_MMA(0, 0, At, B0); PG8_MMA(0, 1, At, B1); PG8_BAR; PG8_SCHED;
            PG8_LDA(At, 0, 1); PG8_STAGE(PG8_SB(0, 0), b2, voffB); PG8_STAGE(PG8_SB(0, 1), b2 + hstep, voffB); PG8_STAGE(PG8_SA(0, 0), a2, voffA);
            PG8_WAIT_V(8); PG8_WAIT_L(0); PG8_BAR; PG8_MMA(1, 0, At, B0); PG8_MMA(1, 1, At, B1); PG8_BAR; PG8_SCHED;
            PG8_LDB(B0, 1, 0); PG8_LDB(B1, 1, 1); PG8_SCHED; PG8_LDA(At, 1, 0); PG8_STAGE(PG8_SA(0, 1), a2 + hstep, voffA);
            PG8_WAIT_V(8); PG8_WAIT_L(0); PG8_BAR; PG8_MMA(0, 0, At, B0); PG8_MMA(0, 1, At, B1); PG8_BAR; PG8_SCHED;
            PG8_LDA(At, 1, 1); PG8_STAGE(PG8_SB(1, 0), b3, voffB); PG8_STAGE(PG8_SB(1, 1), b3 + hstep, voffB); PG8_STAGE(PG8_SA(1, 0), a3, voffA);
            PG8_WAIT_V(8); PG8_WAIT_L(0); PG8_BAR; PG8_MMA(1, 0, At, B0); PG8_MMA(1, 1, At, B1); PG8_BAR; PG8_SCHED;
            } else {
            PG8_LDB(B0, 0, 0); PG8_SCHED; PG8_LDA(At, 0, 0); PG8_STAGE(PG8_SA(1, 1), a1 + hstep, voffA);
            PG8_WAIT_L(8); PG8_BAR; PG8_WAIT_L(0); PG8_MMA(0, 0, At, B0); PG8_BAR; PG8_SCHED;
            PG8_LDB(B1, 0, 1); PG8_STAGE(PG8_SB(0, 0), b2, voffB);
            PG8_BAR; PG8_WAIT_L(0); PG8_MMA(0, 1, At, B1); PG8_BAR;
            PG8_LDA(At, 0, 1); PG8_STAGE(PG8_SA(0, 0), a2, voffA);
            PG8_BAR; PG8_WAIT_L(0); PG8_MMA(1, 0, At, B0); PG8_BAR; PG8_SCHED;
            PG8_STAGE(PG8_SB(0, 1), b2 + hstep, voffB);
            PG8_WAIT_V(6); PG8_BAR; PG8_MMA(1, 1, At, B1); PG8_BAR;
            PG8_LDB(B0, 1, 0); PG8_SCHED; PG8_LDA(At, 1, 0); PG8_STAGE(PG8_SA(0, 1), a2 + hstep, voffA);
            PG8_WAIT_L(8); PG8_BAR; PG8_WAIT_L(0); PG8_MMA(0, 0, At, B0); PG8_BAR; PG8_SCHED;
            PG8_LDB(B1, 1, 1); PG8_STAGE(PG8_SB(1, 0), b3, voffB);
            PG8_BAR; PG8_WAIT_L(0); PG8_MMA(0, 1, At, B1); PG8_BAR;
            PG8_LDA(At, 1, 1); PG8_STAGE(PG8_SA(1, 0), a3, voffA);
            PG8_BAR; PG8_WAIT_L(0); PG8_MMA(1, 0, At, B0); PG8_BAR; PG8_SCHED;
            PG8_STAGE(PG8_SB(1, 1), b3 + hstep, voffB);
            PG8_WAIT_V(6); PG8_BAR; PG8_MMA(1, 1, At, B1); PG8_BAR;
            }
        }
        if constexpr (ALIGN_EPI) { if (wr == 0) PG8_BAR; }
        if constexpr (!Epi::AFTER_DRAIN) { E(acc, cur, ui, wr, wc, fr, fq); S.done(cur); }
        if (!has_next) break;
#pragma unroll
        for (int a = 0; a < 2; ++a)
#pragma unroll
            for (int b = 0; b < 2; ++b)
#pragma unroll
                for (int m = 0; m < 4; ++m)
#pragma unroll
                    for (int n = 0; n < 2; ++n) acc[a][b][m][n] = (f32x4){0.f, 0.f, 0.f, 0.f};
        cur = nxt; cA = nA; cB = nB; ++ui;
        if constexpr (ALIGN_EPI) { if (wr == 1) PG8_BAR; }
    }
    PG8_WAIT_V(0);
    if constexpr (!ALIGN_EPI) { if (wr == 0) PG8_BAR; }
    PG8_BAR;
    if constexpr (Epi::AFTER_DRAIN) { E.fused(acc, cur, wr, wc, fr, fq, lds, wid, lane); S.done(cur); }
#undef PG8_SA
#undef PG8_SB
#undef PG8_STAGE
#undef PG8_LDA
#undef PG8_LDB
#undef PG8_MMA
#undef PG8_WAIT_V
#undef PG8_WAIT_L
#undef PG8_BAR
#undef PG8_SCHED
}
}


#define LAS __attribute__((address_space(3)))
#define GAS __attribute__((address_space(1)))
using pg8::bf16_t; using pg8::bf16x8; using pg8::f32x4; using pg8::u32x4; using pg8::cvt_pk_bf16; using pg8::f32x2; using pg8::gelu_pk;
typedef short s16x4 __attribute__((ext_vector_type(4)));
typedef short v4i16_t __attribute__((ext_vector_type(4)));
typedef unsigned u32x2 __attribute__((ext_vector_type(2)));
constexpr int NB = 4, T = 4096, M = NB * T, D = 1024, NL = 4;
constexpr int NIN = 2688, NPROJ = 2816, DFF = 2816, NCH = 32;
constexpr int C_QR = 0, C_KR = 384, C_VR = 768, C_GR = 1152, C_U = 1536, C_V = 1792, C_QA = 2048, C_KA = 2432, C_VA = 2560;
constexpr int MIX_RET = 0, MIX_MLP = 384, MIX_ATT = 640;
constexpr float EPS = 1e-6f;
constexpr size_t MiB = 1u << 20;
constexpr size_t WS_W1 = 1 * MiB, WS_W2 = 23 * MiB, WS_W3 = 31 * MiB, WS_W4 = 75 * MiB, WS_WSP = 97 * MiB, WS_SSQ = 98 * MiB, WS_KV = 99 * MiB,
                 WS_XB = 111 * MiB, WS_MIX = 143 * MiB, WS_PROJ = 175 * MiB, WS_END = 265 * MiB;
constexpr int LDS_BYTES = 147456, RTAB_OFF = 131072;
constexpr int CONV_IL = 16 * 44 + 16 * 16 + 16 * 88 + 44 * 16, CONV_SPLIT = 16 * 44 + 16 * 16;
constexpr int CONV_FIRST_WG = (64 * 22) % 256;

struct Args { const float* in[14]; float* out; unsigned char* ws; };

__device__ __forceinline__ float wave_sum(float v) {
#pragma unroll
    for (int o = 1; o < 64; o <<= 1) v += __shfl_xor(v, o);
    return v;
}
__device__ __forceinline__ void lds_barrier() { asm volatile("s_waitcnt lgkmcnt(0)" ::: "memory"); __builtin_amdgcn_s_barrier(); asm volatile("" ::: "memory"); }
template <int CTRL> __device__ __forceinline__ float dppf(float x) { return __builtin_bit_cast(float, __builtin_amdgcn_update_dpp(0, __builtin_bit_cast(int, x), CTRL, 0xf, 0xf, true)); }
__device__ __forceinline__ void wave_sum2(float& a, float& b) {
    a += dppf<0xB1>(a); b += dppf<0xB1>(b);
    a += dppf<0x4E>(a); b += dppf<0x4E>(b);
    a += dppf<0x141>(a); b += dppf<0x141>(b);
    a += dppf<0x140>(a); b += dppf<0x140>(b);
    a += __shfl_xor(a, 16); b += __shfl_xor(b, 16);
    a += __shfl_xor(a, 32); b += __shfl_xor(b, 32);
}
__device__ __forceinline__ float bf2f(unsigned short b) { return __uint_as_float(((unsigned)b) << 16); }
__device__ __forceinline__ f32x4 mfma16(bf16x8 a, bf16x8 b, f32x4 c) { return __builtin_amdgcn_mfma_f32_16x16x32_bf16(a, b, c, 0, 0, 0); }
__device__ __forceinline__ s16x4 tr_read(const LAS unsigned char* p) { return __builtin_bit_cast(s16x4, __builtin_amdgcn_ds_read_tr16_b64_v4i16((LAS v4i16_t*)p)); }
__device__ __forceinline__ bf16x8 mk8(s16x4 lo, s16x4 hi) { return (bf16x8){lo[0], lo[1], lo[2], lo[3], hi[0], hi[1], hi[2], hi[3]}; }
__device__ __forceinline__ bf16x8 pack8(f32x4 a, f32x4 b) { u32x4 w; w.x = cvt_pk_bf16(a[0], a[1]); w.y = cvt_pk_bf16(a[2], a[3]); w.z = cvt_pk_bf16(b[0], b[1]); w.w = cvt_pk_bf16(b[2], b[3]); return __builtin_bit_cast(bf16x8, w); }
__device__ __forceinline__ u32x2 pack4(f32x4 a) { u32x2 w; w.x = cvt_pk_bf16(a[0], a[1]); w.y = cvt_pk_bf16(a[2], a[3]); return w; }
__device__ __forceinline__ f32x4 unpack4(u32x2 w) { return (f32x4){__uint_as_float(w.x << 16), __uint_as_float(w.x & 0xffff0000u), __uint_as_float(w.y << 16), __uint_as_float(w.y & 0xffff0000u)}; }

struct EpiProj {
    static constexpr bool PERM = true, AFTER_DRAIN = false;
    GAS bf16_t* O; const LAS float* rtab;
    __device__ __forceinline__ void operator()(const f32x4 (&acc)[2][2][4][2], const pg8::Unit& u, int ui, int wr, int wc, int fr, int fq) const {
        const int row0 = u.pm * 256 + wr * 64 + fr, col0 = u.pn * 256 + wc * 32 + 8 * fq;
        const bool gl = (u.pn == 6 || u.pn == 7);
        float rsv[2][4];
#pragma unroll
        for (int ai = 0; ai < 2; ++ai)
#pragma unroll
            for (int m = 0; m < 4; ++m) rsv[ai][m] = rtab[ui * 256 + wr * 64 + fr + ai * 128 + m * 16];
#pragma unroll
        for (int ai = 0; ai < 2; ++ai)
#pragma unroll
            for (int m = 0; m < 4; ++m) {
                const float rs = rsv[ai][m];
                GAS bf16_t* rowp = O + (size_t)(row0 + ai * 128 + m * 16) * NPROJ + col0;
#pragma unroll
                for (int bj = 0; bj < 2; ++bj) {
                    f32x4 v0 = acc[ai][bj][m][0] * rs, v1 = acc[ai][bj][m][1] * rs;
                    if (gl) { f32x2 a = gelu_pk((f32x2){v0[0], v0[1]}), b = gelu_pk((f32x2){v0[2], v0[3]}), c = gelu_pk((f32x2){v1[0], v1[1]}), d = gelu_pk((f32x2){v1[2], v1[3]});
                        v0 = (f32x4){a.x, a.y, b.x, b.y}; v1 = (f32x4){c.x, c.y, d.x, d.y}; }
                    u32x4 w; w.x = cvt_pk_bf16(v0[0], v0[1]); w.y = cvt_pk_bf16(v0[2], v0[3]); w.z = cvt_pk_bf16(v1[0], v1[1]); w.w = cvt_pk_bf16(v1[2], v1[3]);
                    *(GAS u32x4*)(rowp + bj * 128) = w;
                }
            }
    }
};
struct EpiSwiGLU {
    static constexpr bool PERM = true, AFTER_DRAIN = false;
    GAS bf16_t* O; const LAS float* rtab;
    __device__ __forceinline__ void operator()(const f32x4 (&acc)[2][2][4][2], const pg8::Unit& u, int ui, int wr, int wc, int fr, int fq) const {
        const int row0 = u.pm * 256 + wr * 64 + fr, col0 = u.pn * 128 + wc * 32 + 8 * fq;
        float rsv[2][4];
#pragma unroll
        for (int ai = 0; ai < 2; ++ai)
#pragma unroll
            for (int m = 0; m < 4; ++m) rsv[ai][m] = rtab[ui * 256 + wr * 64 + fr + ai * 128 + m * 16];
#pragma unroll
        for (int ai = 0; ai < 2; ++ai)
#pragma unroll
            for (int m = 0; m < 4; ++m) {
                const float rs = rsv[ai][m];
                f32x4 h[2];
#pragma unroll
                for (int n = 0; n < 2; ++n) {
                    const f32x4 a = acc[ai][0][m][n] * rs, b = acc[ai][1][m][n] * rs;
#pragma unroll
                    for (int j = 0; j < 4; ++j) h[n][j] = a[j] * b[j] * __builtin_amdgcn_rcpf(1.0f + __expf(-a[j]));
                }
                u32x4 w; w.x = cvt_pk_bf16(h[0][0], h[0][1]); w.y = cvt_pk_bf16(h[0][2], h[0][3]); w.z = cvt_pk_bf16(h[1][0], h[1][1]); w.w = cvt_pk_bf16(h[1][2], h[1][3]);
                *(GAS u32x4*)(O + (size_t)(row0 + ai * 128 + m * 16) * DFF + col0) = w;
            }
    }
};
struct EpiResid {
    static constexpr bool PERM = true, AFTER_DRAIN = false;
    GAS bf16_t* xb; GAS float* ssq;
    __device__ __forceinline__ void operator()(const f32x4 (&acc)[2][2][4][2], const pg8::Unit& u, int ui, int wr, int wc, int fr, int fq) const {
        const int row0 = u.pm * 256 + wr * 64 + fr, col0 = u.pn * 256 + wc * 32 + 8 * fq;
#pragma unroll
        for (int ai = 0; ai < 2; ++ai) {
            u32x4 w[4][2];
#pragma unroll
            for (int m = 0; m < 4; ++m)
#pragma unroll
                for (int bj = 0; bj < 2; ++bj) w[m][bj] = *(const GAS u32x4*)(xb + (size_t)(row0 + ai * 128 + m * 16) * D + col0 + bj * 128);
#pragma unroll
            for (int m = 0; m < 4; ++m) {
                const int row = row0 + ai * 128 + m * 16; const size_t off = (size_t)row * D + col0; float q = 0.f;
#pragma unroll
                for (int bj = 0; bj < 2; ++bj) {
                    const f32x4 o0 = unpack4((u32x2){w[m][bj].x, w[m][bj].y}) + acc[ai][bj][m][0], o1 = unpack4((u32x2){w[m][bj].z, w[m][bj].w}) + acc[ai][bj][m][1];
                    *(GAS bf16x8*)(xb + off + bj * 128) = pack8(o0, o1);
                    q += ((o0[0] * o0[0] + o0[1] * o0[1]) + (o0[2] * o0[2] + o0[3] * o0[3])) + ((o1[0] * o1[0] + o1[1] * o1[1]) + (o1[2] * o1[2] + o1[3] * o1[3]));
                }
                q += __shfl_xor(q, 16); q += __shfl_xor(q, 32);
                if (fq == 0) ssq[(size_t)(u.pn * 4 + wc) * M + row] = q;
            }
            asm volatile("" ::: "memory");
        }
    }
};

__device__ __forceinline__ void build_rtab(LAS float* rtab, const pg8::StaticOrder& S, const GAS float* ssq, int tid) {
    float p[3][16]; bool ok[3];
#pragma unroll
    for (int k = 0; k < 3; ++k) { const int idx = tid + 512 * k; pg8::Unit u; ok[k] = S.next(idx >> 8, u);
        if (ok[k]) { const int row = u.pm * 256 + (idx & 255);
#pragma unroll
            for (int j = 0; j < 16; ++j) p[k][j] = ssq[(size_t)j * M + row]; } }
#pragma unroll
    for (int k = 0; k < 3; ++k) if (ok[k]) { float s = 0.f;
#pragma unroll
        for (int j = 0; j < 16; ++j) s += p[k][j];
        rtab[tid + 512 * k] = rsqrtf(s * (1.0f / D) + EPS); }
    for (int idx = tid + 1536; idx < 16 * 256; idx += 512) {
        pg8::Unit u; if (!S.next(idx >> 8, u)) break;
        const int row = u.pm * 256 + (idx & 255); float s = 0.f;
#pragma unroll
        for (int j = 0; j < 16; ++j) s += ssq[(size_t)j * M + row];
        rtab[idx] = rsqrtf(s * (1.0f / D) + EPS);
    }
    __syncthreads();
}

constexpr int TS = 136;
__device__ __forceinline__ void transpose_item(const GAS float* W, int N, int K, int srccol0, float cscale, const GAS float* gk, GAS bf16_t* WT, int drow0, int k0, LAS unsigned char* scr, int lane) {
    const int g4 = lane >> 4, i16 = lane & 15;
    if (srccol0 < 0) {
        const u32x4 z = (u32x4){0u, 0u, 0u, 0u};
#pragma unroll
        for (int nb = 0; nb < 4; ++nb) { GAS bf16_t* o = WT + (size_t)(drow0 + nb * 16 + i16) * K + k0 + 16 * g4; *(GAS u32x4*)o = z; *(GAS u32x4*)(o + 8) = z; }
        return;
    }
    f32x4 v[16];
#pragma unroll
    for (int it = 0; it < 16; ++it) v[it] = __builtin_nontemporal_load((const GAS f32x4*)(W + (size_t)(k0 + 4 * it + g4) * N + srccol0 + 4 * i16));
#pragma unroll
    for (int it = 0; it < 16; ++it) { const float sc = gk ? gk[k0 + 4 * it + g4] * cscale : cscale;
        *(LAS u32x2*)(scr + (4 * it + g4) * TS + i16 * 8) = pack4(v[it] * sc); }
    asm volatile("s_waitcnt lgkmcnt(0)" ::: "memory");
#pragma unroll
    for (int nb = 0; nb < 4; ++nb) {
        const LAS unsigned char* p = scr + (16 * g4 + (i16 >> 2)) * TS + (nb * 16 + 4 * (i16 & 3)) * 2;
        const s16x4 r0 = tr_read(p), r1 = tr_read(p + 4 * TS), r2 = tr_read(p + 8 * TS), r3 = tr_read(p + 12 * TS);
        GAS bf16_t* o = WT + (size_t)(drow0 + nb * 16 + i16) * K + k0 + 16 * g4;
        *(GAS bf16x8*)o = mk8(r0, r1); *(GAS bf16x8*)(o + 8) = mk8(r2, r3);
    }
    asm volatile("s_waitcnt lgkmcnt(0)" ::: "memory");
}

__device__ __forceinline__ void convert_layer_items(const GAS float* n1g, const GAS float* win, const GAS float* wout, const GAS float* n2g, const GAS float* wfi, const GAS float* wfo, GAS unsigned char* ws, int l, int first, int stride, LAS unsigned char* scr, int lane, int lo = 0, int hi = CONV_IL) {
    constexpr int I1 = 16 * 44, I2 = 16 * 16, I3 = 16 * 88, I4 = 44 * 16;
    for (int it = lo + first; it < hi; it += stride) {
        int r = it;
        if (r < I1) { const int kb = r / 44, nb = r % 44, n0 = 64 * nb;
            const float cs = ((n0 >= C_KR && n0 < C_VR) || (n0 >= C_QA && n0 < C_KA)) ? 0.125f : 1.0f;
            transpose_item(win + (size_t)l * D * NIN, NIN, D, n0 < NIN ? n0 : -1, cs, n1g + l * D, (GAS bf16_t*)(ws + WS_W1) + (size_t)l * NPROJ * D, n0, 64 * kb, scr, lane); continue; }
        r -= I1;
        if (r < I2) { const int kb = r / 16, nb = r % 16;
            transpose_item(wout + (size_t)l * D * D, D, D, 64 * nb, 1.0f, nullptr, (GAS bf16_t*)(ws + WS_W2) + (size_t)l * D * D, 64 * nb, 64 * kb, scr, lane); continue; }
        r -= I2;
        if (r < I3) { const int kb = r / 88, nb = r % 88, n0 = 64 * nb, pn = n0 >> 8, bj = (n0 >> 7) & 1, j = n0 & 127;
            transpose_item(wfi + (size_t)l * D * 2 * DFF, 2 * DFF, D, bj * DFF + 128 * pn + j, 1.0f, n2g + l * D, (GAS bf16_t*)(ws + WS_W3) + (size_t)l * 2 * DFF * D, n0, 64 * kb, scr, lane); continue; }
        r -= I3;
        { const int kb = r / 16, nb = r % 16;
            transpose_item(wfo + (size_t)l * DFF * D, D, DFF, 64 * nb, 1.0f, nullptr, (GAS bf16_t*)(ws + WS_W4) + (size_t)l * D * DFF, 64 * nb, 64 * kb, scr, lane); }
    }
}

__device__ __forceinline__ void prologue(const Args& a, LAS unsigned char* lds, int tid) {
    const int lane = tid & 63, wave = tid >> 6, G = gridDim.x;
    const int gw = blockIdx.x * 8 + wave, NGW = G * 8;
    GAS unsigned char* ws = (GAS unsigned char*)a.ws;
    convert_layer_items((const GAS float*)a.in[1], (const GAS float*)a.in[2], (const GAS float*)a.in[9], (const GAS float*)a.in[10], (const GAS float*)a.in[11], (const GAS float*)a.in[12], ws, 0, gw, NGW, lds + wave * 16384, lane, 0, CONV_SPLIT);
    { const GAS float* wsp = (const GAS float*)a.in[6]; GAS bf16_t* o = (GAS bf16_t*)(ws + WS_WSP);
      for (int i = blockIdx.x * 512 + tid; i < NL * 4 * 128 * 128 / 2; i += G * 512) { const int e = 2 * i, jj = e & 127, ii = (e >> 7) & 127;
          const float w0 = jj <= ii ? wsp[e] : 0.f, w1 = (jj + 1) <= ii ? wsp[e + 1] : 0.f; ((GAS unsigned*)o)[i] = cvt_pk_bf16(w0, w1); } }
    { const GAS float* x = (const GAS float*)a.in[0]; GAS bf16_t* xb = (GAS bf16_t*)(ws + WS_XB); GAS float* ssq = (GAS float*)(ws + WS_SSQ);
      for (int row0 = gw; row0 < M; row0 += 4 * NGW) {
          f32x4 v[4][4]; float s[4];
#pragma unroll
          for (int r = 0; r < 4; ++r) { const int row = row0 + r * NGW; if (row < M) { const GAS f32x4* xr = (const GAS f32x4*)(x + (size_t)row * D);
#pragma unroll
              for (int j = 0; j < 4; ++j) v[r][j] = xr[64 * j + lane]; } }
#pragma unroll
          for (int r = 0; r < 4; ++r) { s[r] = 0.f;
#pragma unroll
              for (int j = 0; j < 4; ++j) s[r] += (v[r][j][0] * v[r][j][0] + v[r][j][1] * v[r][j][1]) + (v[r][j][2] * v[r][j][2] + v[r][j][3] * v[r][j][3]); }
          wave_sum2(s[0], s[1]); wave_sum2(s[2], s[3]);
#pragma unroll
          for (int r = 0; r < 4; ++r) { const int row = row0 + r * NGW; if (row < M) { GAS u32x2* o8 = (GAS u32x2*)(xb + (size_t)row * D);
#pragma unroll
              for (int j = 0; j < 4; ++j) o8[64 * j + lane] = pack4(v[r][j]);
              if (lane < 16) ssq[(size_t)lane * M + row] = (lane == 0) ? s[r] : 0.f; } }
      } }
}
__device__ __forceinline__ void final_norm(GAS float* out, const GAS bf16_t* xb, const GAS float* ssq, const GAS float* gfp, int tid) {
    const int lane = tid & 63, wave = tid >> 6, gw = blockIdx.x * 8 + wave, NGW = gridDim.x * 8;
    f32x4 gf[4];
#pragma unroll
    for (int j = 0; j < 2; ++j) { gf[2 * j] = *(const GAS f32x4*)(gfp + 8 * (64 * j + lane)); gf[2 * j + 1] = *(const GAS f32x4*)(gfp + 8 * (64 * j + lane) + 4); }
    for (int row0 = gw; row0 < M; row0 += 4 * NGW) {
        float s[4]; u32x4 w[4][2];
#pragma unroll
        for (int r = 0; r < 4; ++r) { const int row = row0 + r * NGW; s[r] = 0.f; if (row < M) { s[r] = (lane < 16) ? ssq[(size_t)lane * M + row] : 0.f;
            const GAS u32x4* xr = (const GAS u32x4*)(xb + (size_t)row * D); w[r][0] = xr[lane]; w[r][1] = xr[64 + lane]; } }
        wave_sum2(s[0], s[1]); wave_sum2(s[2], s[3]);
#pragma unroll
        for (int r = 0; r < 4; ++r) { const int row = row0 + r * NGW; if (row < M) { const float rs = rsqrtf(s[r] * (1.0f / D) + EPS); GAS f32x4* orow = (GAS f32x4*)(out + (size_t)row * D);
#pragma unroll
            for (int j = 0; j < 2; ++j) { orow[2 * (64 * j + lane)] = unpack4((u32x2){w[r][j].x, w[r][j].y}) * rs * gf[2 * j]; orow[2 * (64 * j + lane) + 1] = unpack4((u32x2){w[r][j].z, w[r][j].w}) * rs * gf[2 * j + 1]; } } }
    }
}


constexpr int MISC_OFF = 139264;
constexpr int RS = 144;
constexpr int VS = 528;
constexpr size_t WS_TOT = 263 * MiB;

constexpr int WSCR_OFF = 118784, WSCR_STRIDE = 144, WSCR_BYTES = 16 * WSCR_STRIDE;
__device__ __forceinline__ void store_tile16x64(LAS unsigned char* wscr, const u32x2 (&pk)[4], GAS bf16_t* dst  , int lane) {
    const int g4 = lane >> 4, i16 = lane & 15;
#pragma unroll
    for (int et = 0; et < 4; ++et) *(LAS u32x2*)(wscr + i16 * WSCR_STRIDE + et * 32 + g4 * 8) = pk[et];
    asm volatile("s_waitcnt lgkmcnt(0)" ::: "memory");
    u32x4 v[2];
#pragma unroll
    for (int hh = 0; hh < 2; ++hh) v[hh] = *(const LAS u32x4*)(wscr + ((lane >> 3) + 8 * hh) * WSCR_STRIDE + (lane & 7) * 16);
    asm volatile("s_waitcnt lgkmcnt(0)" ::: "memory");
#pragma unroll
    for (int hh = 0; hh < 2; ++hh) *(GAS u32x4*)(dst + (size_t)((lane >> 3) + 8 * hh) * D + (lane & 7) * 8) = v[hh];
}
__device__ __forceinline__ void store_tile16x32(LAS unsigned char* wscr, const u32x2 (&pk)[2], GAS bf16_t* dst, int lane) {
    const int g4 = lane >> 4, i16 = lane & 15;
#pragma unroll
    for (int cc = 0; cc < 2; ++cc) *(LAS u32x2*)(wscr + i16 * WSCR_STRIDE + cc * 32 + g4 * 8) = pk[cc];
    asm volatile("s_waitcnt lgkmcnt(0)" ::: "memory");
    const u32x4 v = *(const LAS u32x4*)(wscr + (lane >> 2) * WSCR_STRIDE + (lane & 3) * 16);
    asm volatile("s_waitcnt lgkmcnt(0)" ::: "memory");
    *(GAS u32x4*)(dst + (size_t)(lane >> 2) * D + (lane & 3) * 8) = v;
}

__device__ __forceinline__ void attn_job(LAS unsigned char* lds, const GAS bf16_t* proj, GAS bf16_t* mixed, const GAS float* sinks, int job, int tid) {
    const int kvh = job & 1, n = (job >> 1) & 31, b = job >> 6;
    const int lane = tid & 63, wid = tid >> 6, g4 = lane >> 4, i16 = lane & 15;
    LAS unsigned char* Kl = lds; LAS unsigned char* Vl = lds + 256 * RS;
    u32x4 kr[4], vr[4];
#pragma unroll
    for (int i = 0; i < 4; ++i) { const int c = tid + 512 * i, row = c >> 3, ch = c & 7;
        kr[i] = (u32x4){0u, 0u, 0u, 0u}; vr[i] = kr[i];
        if (n > 0 || row >= 128) { const GAS bf16_t* p = proj + (size_t)(b * T + n * 128 - 128 + row) * NPROJ; kr[i] = *(const GAS u32x4*)(p + C_KA + kvh * 64 + ch * 8); vr[i] = *(const GAS u32x4*)(p + C_VA + kvh * 64 + ch * 8); } }
    bf16x8 qf[3][2]; float sk[3];
#pragma unroll
    for (int qt = 0; qt < 3; ++qt) { const int t = wid * 3 + qt, g = t >> 3, aa = t & 7, h = kvh * 3 + g; sk[qt] = sinks[h];
        const GAS bf16_t* qp = proj + ((size_t)b * T + n * 128 + 16 * aa + i16) * NPROJ + C_QA + h * 64 + 8 * g4;
        qf[qt][0] = *(const GAS bf16x8*)qp; qf[qt][1] = *(const GAS bf16x8*)(qp + 32); }
#pragma unroll
    for (int i = 0; i < 4; ++i) { const int c = tid + 512 * i, row = c >> 3, ch = c & 7;
        *(LAS u32x4*)(Kl + row * RS + ch * 16) = kr[i]; *(LAS u32x4*)(Vl + row * RS + ch * 16) = vr[i]; }
    lds_barrier();
#pragma unroll 1
    for (int qt = 0; qt < 3; ++qt) {
        const int t = wid * 3 + qt, g = t >> 3, aa = t & 7, h = kvh * 3 + g;
        const float slope = (h == 0) ? 0.25f : (h == 1) ? 0.0625f : (h == 2) ? 0.015625f : (h == 3) ? 0.00390625f : (h == 4) ? 0.5f : 0.125f;
        const float sink = qt == 0 ? sk[0] : (qt == 1 ? sk[1] : sk[2]);
        const int iq = 16 * aa + i16; const size_t tok = (size_t)b * T + n * 128 + iq;
        const bf16x8 q0 = qt == 0 ? qf[0][0] : (qt == 1 ? qf[1][0] : qf[2][0]), q1 = qt == 0 ? qf[0][1] : (qt == 1 ? qf[1][1] : qf[2][1]);
        const int kb0 = aa >> 1;
        f32x4 s[10];
#pragma unroll
        for (int kt = 0; kt < 10; ++kt) { const LAS unsigned char* kp = Kl + ((kb0 * 2 + kt) * 16 + i16) * RS + g4 * 16;
            const bf16x8 k0 = *(const LAS bf16x8*)kp, k1 = *(const LAS bf16x8*)(kp + 64);
            f32x4 z = (f32x4){0.f, 0.f, 0.f, 0.f}; z = mfma16(k0, q0, z); z = mfma16(k1, q1, z); s[kt] = z; }
        float mx = sink;
#pragma unroll
        for (int kt = 0; kt < 10; ++kt)
#pragma unroll
            for (int r = 0; r < 4; ++r) { const int kj = (kb0 * 2 + kt) * 16 + 4 * g4 + r, dist = 128 + iq - kj;
                const bool ok = dist >= 0 && dist < 128 && (n > 0 || kj >= 128);
                const float v = ok ? s[kt][r] - slope * (float)dist : -1e30f; s[kt][r] = v; mx = fmaxf(mx, v); }
        mx = fmaxf(mx, __shfl_xor(mx, 16)); mx = fmaxf(mx, __shfl_xor(mx, 32));
        float sum = 0.f;
#pragma unroll
        for (int kt = 0; kt < 10; ++kt)
#pragma unroll
            for (int r = 0; r < 4; ++r) { const float p = __expf(s[kt][r] - mx); s[kt][r] = p; sum += p; }
        sum += __shfl_xor(sum, 16); sum += __shfl_xor(sum, 32);
        const float inv = 1.0f / (sum + __expf(sink - mx));
        f32x4 o[4];
#pragma unroll
        for (int et = 0; et < 4; ++et) o[et] = (f32x4){0.f, 0.f, 0.f, 0.f};
#pragma unroll
        for (int kb = 0; kb < 5; ++kb) { const bf16x8 pb = pack8(s[2 * kb], s[2 * kb + 1]);
#pragma unroll
            for (int et = 0; et < 4; ++et) { const LAS unsigned char* vp = Vl + ((kb0 + kb) * 32 + 4 * g4 + (i16 >> 2)) * RS + (et * 16 + 4 * (i16 & 3)) * 2;
                o[et] = mfma16(mk8(tr_read(vp), tr_read(vp + 16 * RS)), pb, o[et]); } }
        u32x2 pk[4];
#pragma unroll
        for (int et = 0; et < 4; ++et) pk[et] = pack4(o[et] * inv);
        store_tile16x64(lds + WSCR_OFF + wid * WSCR_BYTES, pk, mixed + ((size_t)b * T + n * 128 + 16 * aa) * D + MIX_ATT + h * 64, lane);
    }
}

__device__ __forceinline__ void gmlp_job(LAS unsigned char* lds, const GAS bf16_t* proj, GAS bf16_t* mixed, const GAS bf16_t* wsb, const GAS float* bsp, const GAS float* lng, const GAS float* lnb, int job, int tid) {
    const int n = job & 31, b = job >> 5;
    const int lane = tid & 63, wid = tid >> 6, g4 = lane >> 4, i16 = lane & 15;
    const size_t tok0 = (size_t)b * T + n * 128;
    const int ct0 = 2 * wid, grp = wid >> 1;
    const GAS bf16_t* wg = wsb + (size_t)grp * 128 * 128 + (size_t)i16 * 128 + 8 * g4;
    bf16x8 wf[4][8]; u32x2 ur[8][2]; float bsv[8];
    { const f32x4 gg = *(const GAS f32x4*)(lng + 4 * lane), bb = *(const GAS f32x4*)(lnb + 4 * lane);
      u32x2 xr[16];
#pragma unroll
      for (int rr = 0; rr < 16; ++rr) xr[rr] = *(const GAS u32x2*)(proj + (tok0 + 16 * wid + rr) * NPROJ + C_V + 4 * lane);
#pragma unroll
      for (int kb = 0; kb < 4; ++kb)
#pragma unroll
          for (int aa = 2 * kb; aa < 8; ++aa) wf[kb][aa] = *(const GAS bf16x8*)(wg + (size_t)(16 * aa) * 128 + 32 * kb);
#pragma unroll
      for (int aa = 0; aa < 8; ++aa) { bsv[aa] = bsp[grp * 128 + 16 * aa + i16];
#pragma unroll
          for (int cc = 0; cc < 2; ++cc) ur[aa][cc] = *(const GAS u32x2*)(proj + (tok0 + 16 * aa + i16) * NPROJ + C_U + (ct0 + cc) * 16 + 4 * g4); }
#pragma unroll
      for (int rr = 0; rr < 16; ++rr) { const int row = 16 * wid + rr;
          const f32x4 x = unpack4(xr[rr]);
          float s1 = (x[0] + x[1]) + (x[2] + x[3]), s2 = (x[0] * x[0] + x[1] * x[1]) + (x[2] * x[2] + x[3] * x[3]);
          wave_sum2(s1, s2);
          const float mu = s1 * (1.0f / 256.0f);
          const f32x4 d = x - mu;
          const float var = fmaxf(s2 * (1.0f / 256.0f) - mu * mu, 0.f);
          const float rs = rsqrtf(var + EPS);
          *(LAS u32x2*)(lds + row * VS + lane * 8) = pack4(d * rs * gg + bb); } }
    lds_barrier();
    f32x4 acc[8][2];
#pragma unroll
    for (int aa = 0; aa < 8; ++aa) { acc[aa][0] = (f32x4){0.f, 0.f, 0.f, 0.f}; acc[aa][1] = acc[aa][0]; }
#pragma unroll
    for (int kb = 0; kb < 4; ++kb) {
        bf16x8 af[2];
#pragma unroll
        for (int cc = 0; cc < 2; ++cc) { const LAS unsigned char* vp = lds + (32 * kb + 8 * g4 + (i16 >> 2)) * VS + ((ct0 + cc) * 16 + 4 * (i16 & 3)) * 2; af[cc] = mk8(tr_read(vp), tr_read(vp + 4 * VS)); }
#pragma unroll
        for (int aa = 2 * kb; aa < 8; ++aa)
#pragma unroll
            for (int cc = 0; cc < 2; ++cc) acc[aa][cc] = mfma16(af[cc], wf[kb][aa], acc[aa][cc]);
    }
#pragma unroll
    for (int aa = 0; aa < 8; ++aa) {
        u32x2 pk[2];
#pragma unroll
        for (int cc = 0; cc < 2; ++cc) pk[cc] = pack4(unpack4(ur[aa][cc]) * (acc[aa][cc] + bsv[aa]));
        store_tile16x32(lds + WSCR_OFF + wid * WSCR_BYTES, pk, mixed + (tok0 + 16 * aa) * D + MIX_MLP + ct0 * 16, lane);
    }
}

__device__ __forceinline__ void kvoct_job(LAS unsigned char* lds, const GAS bf16_t* proj, GAS float* Pb, GAS float* Tot, int job, int tid) {
    const int o = job & 3, h = (job >> 2) % 6, b = job / 24;
    const int lane = tid & 63, wid = tid >> 6, g4 = lane >> 4, i16 = lane & 15;
    const float lg2 = log2f(1.0f - exp2f(-5.0f - (float)h)), cd = exp2f(lg2 * 128.0f);
    const int et = wid >> 1, dt0 = (wid & 1) * 2;
    const int row0 = tid >> 3, ch = tid & 7;
    const float tl0 = exp2f(lg2 * (float)(127 - row0)), tl1 = exp2f(lg2 * (float)(63 - row0));
    const GAS bf16_t* src = proj + ((size_t)b * T + (size_t)(8 * o) * 128 + row0) * NPROJ + h * 64 + ch * 8;
    u32x4 kk[4][2], vv[4][2];
#pragma unroll
    for (int s = 0; s < 4; ++s) { const GAS bf16_t* s2 = src + (size_t)s * 128 * NPROJ;
        kk[s][0] = *(const GAS u32x4*)(s2 + C_KR); vv[s][0] = *(const GAS u32x4*)(s2 + C_VR); kk[s][1] = *(const GAS u32x4*)(s2 + (size_t)64 * NPROJ + C_KR); vv[s][1] = *(const GAS u32x4*)(s2 + (size_t)64 * NPROJ + C_VR); }
    f32x4 P[2]; P[0] = (f32x4){0.f, 0.f, 0.f, 0.f}; P[1] = P[0];
    GAS float* po = Pb + ((size_t)((b * 6 + h) * 32 + 8 * o)) * 4096 + (et * 16 + i16) * 64 + dt0 * 16 + 4 * g4;
#pragma unroll
    for (int c = 0; c < 8; ++c) {
        const int s = c & 3;
        LAS unsigned char* Kl = lds + (c & 1) * (256 * RS); LAS unsigned char* Vl = Kl + 128 * RS;
        *(LAS bf16x8*)(Kl + row0 * RS + ch * 16) = pack8(unpack4((u32x2){kk[s][0].x, kk[s][0].y}) * tl0, unpack4((u32x2){kk[s][0].z, kk[s][0].w}) * tl0);
        *(LAS bf16x8*)(Kl + (row0 + 64) * RS + ch * 16) = pack8(unpack4((u32x2){kk[s][1].x, kk[s][1].y}) * tl1, unpack4((u32x2){kk[s][1].z, kk[s][1].w}) * tl1);
        *(LAS u32x4*)(Vl + row0 * RS + ch * 16) = vv[s][0]; *(LAS u32x4*)(Vl + (row0 + 64) * RS + ch * 16) = vv[s][1];
        if (c + 4 < 8) { const GAS bf16_t* s2 = src + (size_t)(c + 4) * 128 * NPROJ;
            kk[s][0] = *(const GAS u32x4*)(s2 + C_KR); vv[s][0] = *(const GAS u32x4*)(s2 + C_VR); kk[s][1] = *(const GAS u32x4*)(s2 + (size_t)64 * NPROJ + C_KR); vv[s][1] = *(const GAS u32x4*)(s2 + (size_t)64 * NPROJ + C_VR); }
        lds_barrier();
        *(GAS f32x4*)(po + (size_t)c * 4096) = P[0]; *(GAS f32x4*)(po + (size_t)c * 4096 + 16) = P[1];
        f32x4 acc[2]; acc[0] = (f32x4){0.f, 0.f, 0.f, 0.f}; acc[1] = acc[0];
#pragma unroll
        for (int ks = 0; ks < 4; ++ks) {
            const int rowb = 32 * ks + 8 * g4 + (i16 >> 2);
            const LAS unsigned char* vp = Vl + rowb * RS + (et * 16 + 4 * (i16 & 3)) * 2;
            const bf16x8 vf = mk8(tr_read(vp), tr_read(vp + 4 * RS));
#pragma unroll
            for (int dd = 0; dd < 2; ++dd) { const LAS unsigned char* kp = Kl + rowb * RS + ((dt0 + dd) * 16 + 4 * (i16 & 3)) * 2;
                acc[dd] = mfma16(mk8(tr_read(kp), tr_read(kp + 4 * RS)), vf, acc[dd]); }
        }
        P[0] = P[0] * cd + acc[0]; P[1] = P[1] * cd + acc[1];
    }
    GAS float* to = Tot + ((size_t)((b * 6 + h) * 4 + o)) * 4096 + (et * 16 + i16) * 64 + dt0 * 16 + 4 * g4;
    *(GAS f32x4*)to = P[0]; *(GAS f32x4*)(to + 16) = P[1];
}

struct RetRegs { u32x4 k0, k1, v0, v1; f32x4 s0, s1, t0[3], t1[3]; bf16x8 q0, q1; u32x2 gtr[4]; f32x4 rg[4]; };
constexpr int RET_BUF = 320 * RS;
__device__ __forceinline__ void ret_load(RetRegs& R, const GAS bf16_t* proj, const GAS float* Pb, const GAS float* Tot, const GAS float* retg, int job, int tid) {
    const int n = job & 31, h = (job >> 5) % 6, b = job / 192;
    const int lane = tid & 63, wid = tid >> 6, g4 = lane >> 4, i16 = lane & 15;
    const size_t tok0 = (size_t)b * T + n * 128, tok = tok0 + 16 * wid + i16;
    const int row0 = tid >> 3, ch = tid & 7;
    const GAS bf16_t* src = proj + (tok0 + row0) * NPROJ + h * 64 + ch * 8;
    R.k0 = *(const GAS u32x4*)(src + C_KR); R.v0 = *(const GAS u32x4*)(src + C_VR); R.k1 = *(const GAS u32x4*)(src + (size_t)64 * NPROJ + C_KR); R.v1 = *(const GAS u32x4*)(src + (size_t)64 * NPROJ + C_VR);
    const int oc = n >> 3;
    const GAS float* pp = Pb + ((size_t)((b * 6 + h) * 32 + n)) * 4096 + tid * 8;
    R.s0 = *(const GAS f32x4*)pp; R.s1 = *(const GAS f32x4*)(pp + 4);
#pragma unroll
    for (int oo = 0; oo < 3; ++oo) { const int os = oo < oc ? oo : 0; const GAS float* tp = Tot + ((size_t)((b * 6 + h) * 4 + os)) * 4096 + tid * 8;
        R.t0[oo] = *(const GAS f32x4*)tp; R.t1[oo] = *(const GAS f32x4*)(tp + 4); }
    const GAS bf16_t* qp = proj + tok * NPROJ + C_QR + h * 64 + 8 * g4;
    R.q0 = *(const GAS bf16x8*)qp; R.q1 = *(const GAS bf16x8*)(qp + 32);
#pragma unroll
    for (int et = 0; et < 4; ++et) { const int c = h * 64 + et * 16 + 4 * g4; R.gtr[et] = *(const GAS u32x2*)(proj + tok * NPROJ + C_GR + c); R.rg[et] = *(const GAS f32x4*)(retg + c); }
}
__device__ __forceinline__ void ret_stage(const RetRegs& R, LAS unsigned char* buf, int job, int tid) {
    const int n = job & 31, h = (job >> 5) % 6, oc = n >> 3;
    const float lg2 = log2f(1.0f - exp2f(-5.0f - (float)h));
    LAS unsigned char* Kl = buf; LAS unsigned char* Vl = buf + 128 * RS; LAS unsigned char* Sl = buf + 256 * RS;
    const int row0 = tid >> 3, ch = tid & 7;
    *(LAS u32x4*)(Kl + row0 * RS + ch * 16) = R.k0; *(LAS u32x4*)(Kl + (row0 + 64) * RS + ch * 16) = R.k1;
    *(LAS u32x4*)(Vl + row0 * RS + ch * 16) = R.v0; *(LAS u32x4*)(Vl + (row0 + 64) * RS + ch * 16) = R.v1;
    f32x4 s0 = R.s0, s1 = R.s1;
#pragma unroll
    for (int oo = 0; oo < 3; ++oo) { const float tf = oo < oc ? exp2f(lg2 * 128.0f * (float)(n - 8 * (oo + 1))) : 0.f; s0 = s0 + R.t0[oo] * tf; s1 = s1 + R.t1[oo] * tf; }
    *(LAS bf16x8*)(Sl + (tid >> 3) * RS + (tid & 7) * 16) = pack8(s0, s1);
}
__device__ __forceinline__ void ret_compute(const RetRegs& R, const LAS unsigned char* buf, LAS unsigned char* wscr, GAS bf16_t* mixed, int job, int tid) {
    const int n = job & 31, h = (job >> 5) % 6, b = job / 192;
    const int lane = tid & 63, wid = tid >> 6, g4 = lane >> 4, i16 = lane & 15;
    const float lg2 = log2f(1.0f - exp2f(-5.0f - (float)h));
    const LAS unsigned char* Kl = buf; const LAS unsigned char* Vl = buf + 128 * RS; const LAS unsigned char* Sl = buf + 256 * RS;
    const int aa = wid, iq = 16 * aa + i16; const size_t tok = (size_t)b * T + n * 128 + iq;
    const bf16x8 q0 = R.q0, q1 = R.q1;
    f32x4 o[4];
#pragma unroll
    for (int et = 0; et < 4; ++et) o[et] = (f32x4){0.f, 0.f, 0.f, 0.f};
    f32x4 s[4][2];
#pragma unroll
    for (int kb = 0; kb < 4; ++kb)
#pragma unroll
        for (int tt = 0; tt < 2; ++tt) { const LAS unsigned char* kp = Kl + ((2 * kb + tt) * 16 + i16) * RS + g4 * 16;
            const bf16x8 ka = *(const LAS bf16x8*)kp, kb2 = *(const LAS bf16x8*)(kp + 64);
            f32x4 z = (f32x4){0.f, 0.f, 0.f, 0.f}; z = mfma16(ka, q0, z); z = mfma16(kb2, q1, z); s[kb][tt] = z; }
#pragma unroll
    for (int kb = 0; kb < 4; ++kb)
#pragma unroll
        for (int tt = 0; tt < 2; ++tt)
#pragma unroll
            for (int r = 0; r < 4; ++r) { const int dl = iq - ((2 * kb + tt) * 16 + 4 * g4 + r); s[kb][tt][r] = dl >= 0 ? s[kb][tt][r] * __builtin_amdgcn_exp2f(lg2 * (float)dl) : 0.f; }
#pragma unroll
    for (int kb = 0; kb < 4; ++kb) {
        const bf16x8 pb = pack8(s[kb][0], s[kb][1]);
#pragma unroll
        for (int et = 0; et < 4; ++et) { const LAS unsigned char* vp = Vl + (kb * 32 + 4 * g4 + (i16 >> 2)) * RS + (et * 16 + 4 * (i16 & 3)) * 2;
            o[et] = mfma16(mk8(tr_read(vp), tr_read(vp + 16 * RS)), pb, o[et]); }
    }
    { const float hd = exp2f(lg2 * (float)(iq + 1));
#pragma unroll
      for (int et = 0; et < 4; ++et) { const LAS unsigned char* sp = Sl + (et * 16 + i16) * RS + g4 * 16;
          f32x4 z = (f32x4){0.f, 0.f, 0.f, 0.f}; z = mfma16(*(const LAS bf16x8*)sp, q0, z); z = mfma16(*(const LAS bf16x8*)(sp + 64), q1, z);
          o[et] = o[et] + z * hd; } }
    float ss = 0.f;
#pragma unroll
    for (int et = 0; et < 4; ++et) ss += (o[et][0] * o[et][0] + o[et][1] * o[et][1]) + (o[et][2] * o[et][2] + o[et][3] * o[et][3]);
    ss += __shfl_xor(ss, 16); ss += __shfl_xor(ss, 32);
    const float rinv = rsqrtf(ss * (1.0f / 64.0f) + EPS);
    u32x2 pk[4];
#pragma unroll
    for (int et = 0; et < 4; ++et) {
        const f32x4 gt = unpack4(R.gtr[et]);
        f32x4 y;
#pragma unroll
        for (int r = 0; r < 4; ++r) y[r] = o[et][r] * rinv * R.rg[et][r] * gt[r] * __builtin_amdgcn_rcpf(1.0f + __expf(-gt[r]));
        pk[et] = pack4(y); }
    store_tile16x64(wscr, pk, mixed + ((size_t)b * T + n * 128 + 16 * aa) * D + MIX_RET + h * 64, lane);
}

#define RLX_AGENT __ATOMIC_RELAXED, __HIP_MEMORY_SCOPE_AGENT
#define XB_TMO      128
#define XB_XCNT(j)  (256  + 64 * (j))
#define XB_XSUB(j)  (1280 + 64 * (j))
#define XB_XGEN(j)  (2304 + 64 * (j))
#define XB_TOP      3328
#define XB_TOPGEN   3392
#define XCD_BAR_WORDS 3456
#define XB_SPIN_CAP (1u << 18)

__device__ __forceinline__ unsigned xb_ld(unsigned* p)              { return __hip_atomic_load(p, __ATOMIC_RELAXED, __HIP_MEMORY_SCOPE_AGENT); }
__device__ __forceinline__ unsigned xb_add(unsigned* p, unsigned v) { return __hip_atomic_fetch_add(p, v, __ATOMIC_RELAXED, __HIP_MEMORY_SCOPE_AGENT); }
__device__ __forceinline__ unsigned xb_xcc_id() { return (unsigned)__builtin_amdgcn_s_getreg((3 << 11) | 20) & 0xFu; }
#define XB_SPIN(cond, bar) do { unsigned _sp = 0; while (cond) { __builtin_amdgcn_s_sleep(1); \
    if ((++_sp & 255u) == 0u) { if (xb_ld(&(bar)[XB_TMO])) break; if (_sp > XB_SPIN_CAP) { atomicAdd(&(bar)[XB_TMO], 1u); break; } } } } while (0)

struct XcdBarrier {
    unsigned* bar; unsigned x;
    volatile LAS unsigned* st;
};

__device__ __forceinline__ XcdBarrier xcd_barrier_post(unsigned* bar, volatile LAS unsigned* st) {
    XcdBarrier b; b.bar = bar; b.x = xb_xcc_id(); b.st = st;
    if (threadIdx.x == 0) (void)xb_add(&bar[XB_XCNT(b.x)], 1u);
    return b;
}
__device__ __forceinline__ void xcd_barrier_complete(unsigned* bar, unsigned x, unsigned& nloc, unsigned& nx) {
    const unsigned G = gridDim.x * gridDim.y * gridDim.z;
    unsigned sum, cnt, mine, sp = 0u;
    for (;;) {
        sum = 0u; cnt = 0u; mine = 0u;
#pragma unroll
        for (unsigned j = 0; j < 16; ++j) { const unsigned c = xb_ld(&bar[XB_XCNT(j)]); sum += c; cnt += (c > 0u) ? 1u : 0u; mine = (j == x) ? c : mine; }
        if (sum == G) break;
        __builtin_amdgcn_s_sleep(1);
        if ((++sp & 255u) == 0u) { if (xb_ld(&bar[XB_TMO])) break; if (sp > XB_SPIN_CAP) { atomicAdd(&bar[XB_TMO], 1u); break; } }
    }
    nloc = mine > 0u ? mine : 1u; nx = cnt > 0u ? cnt : 1u;
}

__device__ __forceinline__ void xcd_barrier(const XcdBarrier& b) {
    asm volatile("s_waitcnt vmcnt(0)" ::: "memory");
    __syncthreads();
    if (threadIdx.x == 0) {
        unsigned* bar = b.bar;
        __builtin_amdgcn_s_waitcnt(0);
        unsigned nloc = b.st[0], nx = b.st[1];
        if (nloc == 0u) { xcd_barrier_complete(bar, b.x, nloc, nx); b.st[0] = nloc; b.st[1] = nx; }
        const unsigned old = xb_add(&bar[XB_XSUB(b.x)], 1u);
        const unsigned gen = old / nloc;
        if (old + 1u == (gen + 1u) * nloc) {
            __builtin_amdgcn_fence(__ATOMIC_RELEASE, "agent");
            asm volatile("s_waitcnt vmcnt(0)" ::: "memory");
            const unsigned og = xb_add(&bar[XB_TOP], 1u);
            const unsigned tg = og / nx;
            if (og + 1u == (tg + 1u) * nx) xb_add(&bar[XB_TOPGEN], 1u);
            else XB_SPIN(xb_ld(&bar[XB_TOPGEN]) == tg, bar);
            __builtin_amdgcn_fence(__ATOMIC_ACQUIRE, "agent");
            xb_add(&bar[XB_XGEN(b.x)], 1u);
            asm volatile("s_waitcnt vmcnt(0)" ::: "memory");
        } else {
            XB_SPIN(xb_ld(&bar[XB_TOPGEN]) == gen, bar);
            __builtin_amdgcn_fence(__ATOMIC_ACQUIRE, "agent");
            asm volatile("s_waitcnt vmcnt(0)" ::: "memory");
        }
    }
    __syncthreads();
}

constexpr size_t WS_BAR = 65536;
__device__ __forceinline__ GAS unsigned char* launder_ptr(unsigned char* p) {
    unsigned lo = (unsigned)(unsigned long long)p, hi = (unsigned)((unsigned long long)p >> 32); asm volatile("" : "+v"(lo), "+v"(hi));
    lo = __builtin_amdgcn_readfirstlane(lo); hi = __builtin_amdgcn_readfirstlane(hi); return (GAS unsigned char*)(((unsigned long long)hi << 32) | lo);
}
__device__ __forceinline__ int retjob(int bb, int idx, int nhalf, int k) { const int q = idx * 3 + k; return bb * 192 + (q >> 4) * 32 + nhalf + (q & 15); }
__device__ __forceinline__ void kv_wait(unsigned* kvc, int tid) {
    if (tid == 0) { unsigned sp = 0; while (__hip_atomic_load(kvc, __ATOMIC_RELAXED, __HIP_MEMORY_SCOPE_AGENT) < 96u) { __builtin_amdgcn_s_sleep(2); if (++sp > (1u << 22)) break; }
        __builtin_amdgcn_fence(__ATOMIC_ACQUIRE, "agent"); asm volatile("s_waitcnt vmcnt(0)" ::: "memory"); }
    lds_barrier();
}
#define PH(k, ...) do { int tid = threadIdx.x; asm volatile("" : "+v"(tid)); int bid_ = blockIdx.x; asm volatile("" : "+v"(bid_)); const int bid = __builtin_amdgcn_readfirstlane(bid_); (void)bid; \
    GAS unsigned char* ws = launder_ptr(a.ws); __VA_ARGS__ } while (0)
#define GSYNC() xcd_barrier(bar)
#define PTAB(i) ((const GAS float*)(((const GAS unsigned long long*)ws)[i]))
__global__ void __launch_bounds__(512, 2) fwd_mega(Args a) {
    extern __shared__ __attribute__((aligned(16))) unsigned char lds_raw[];
    LAS unsigned char* lds = (LAS unsigned char*)lds_raw;
    cg::grid_group grid = cg::this_grid();
    if (a.ws == nullptr) grid.sync();
    { volatile LAS unsigned* misc = (volatile LAS unsigned*)(lds + MISC_OFF); if (threadIdx.x < 32) misc[threadIdx.x] = 0u; __syncthreads(); }
    const XcdBarrier bar = xcd_barrier_post((unsigned*)(a.ws + WS_BAR), (volatile LAS unsigned*)(lds + MISC_OFF + 32));
    PH(6, { prologue(a, lds, tid); if (blockIdx.x == 0 && tid == 0) { _Pragma("unroll") for (int i_ = 0; i_ < 14; ++i_) ((GAS unsigned long long*)ws)[i_] = (unsigned long long)a.in[i_]; } });
    GSYNC();
#pragma unroll 1
    for (int l = 0; l < NL; ++l) {
        PH(0, {
            pg8::Gemm g{(const bf16_t*)(ws + WS_XB), (const bf16_t*)(ws + WS_W1) + (size_t)l * NPROJ * D, M, NPROJ, D}; pg8::StaticOrder S; S.init(M, NPROJ, (int)gridDim.x, bid);
            LAS float* rtab = (LAS float*)(lds + RTAB_OFF);
            build_rtab(rtab, S, (const GAS float*)(ws + WS_SSQ), tid);
            EpiProj E{(GAS bf16_t*)(ws + WS_PROJ), rtab};
            pg8::gemm_phase<EpiProj, pg8::StaticOrder, true, true>(lds, g, S, E);
            if (l == 0 && bid >= 192)
                convert_layer_items(PTAB(1), PTAB(2), PTAB(9), PTAB(10), PTAB(11), PTAB(12), ws, 0, (bid - 192) * 8 + (tid >> 6), ((int)gridDim.x - 192) * 8, lds + (tid >> 6) * 16384, tid & 63, CONV_SPLIT, CONV_IL); });
        GSYNC();
        PH(1, {
            const GAS bf16_t* PROJ = (const GAS bf16_t*)(ws + WS_PROJ); GAS bf16_t* MIX = (GAS bf16_t*)(ws + WS_MIX);
            unsigned* kvcnt = (unsigned*)(ws + WS_BAR) + 4096 + 64 * l;
            const int c = bid;
            if (gridDim.x == 256) {
                unsigned* kvc = kvcnt;
                const GAS float* Pb = (const GAS float*)(ws + WS_KV); const GAS float* Tot = (const GAS float*)(ws + WS_TOT); const GAS float* retg = PTAB(3) + l * 384;
                const int xcd = c & 7, idx = c >> 3, bb = xcd >> 1, nhalf = (xcd & 1) * 16;
                const int nj = 3;
                if (c < 96) {
                    kvoct_job(lds, PROJ, (GAS float*)(ws + WS_KV), (GAS float*)(ws + WS_TOT), bb * 24 + (idx % 6) * 4 + (xcd & 1) * 2 + idx / 6, tid);
                    asm volatile("s_waitcnt vmcnt(0)" ::: "memory"); lds_barrier();
                    if (tid == 0) { __builtin_amdgcn_fence(__ATOMIC_RELEASE, "agent"); asm volatile("s_waitcnt vmcnt(0)" ::: "memory"); __hip_atomic_fetch_add(kvc, 1u, __ATOMIC_RELAXED, __HIP_MEMORY_SCOPE_AGENT); }
                } else if (c < 224) gmlp_job(lds, PROJ, MIX, (const GAS bf16_t*)(ws + WS_WSP) + (size_t)l * 4 * 128 * 128, PTAB(7) + l * 512, PTAB(4) + l * 256, PTAB(5) + l * 256, (bb << 5) | (nhalf + idx - 12), tid);
                lds_barrier();
                attn_job(lds, PROJ, MIX, PTAB(8) + l * 6, (bb << 6) | ((nhalf + (idx >> 1)) << 1) | (idx & 1), tid);
                kv_wait(kvc, tid);
                RetRegs cur;
                ret_load(cur, PROJ, Pb, Tot, retg, retjob(bb, idx, nhalf, 0), tid);
                lds_barrier();
                _Pragma("unroll 1") for (int k = 0; k < nj; ++k) {
                    LAS unsigned char* buf = lds + (k & 1) * RET_BUF;
                    ret_stage(cur, buf, retjob(bb, idx, nhalf, k), tid);
                    lds_barrier();
                    RetRegs nxt; ret_load(nxt, PROJ, Pb, Tot, retg, retjob(bb, idx, nhalf, k + 1 < nj ? k + 1 : k), tid);
                    ret_compute(cur, buf, lds + WSCR_OFF + (tid >> 6) * WSCR_BYTES, MIX, retjob(bb, idx, nhalf, k), tid);
                    cur = nxt;
                }
            } });
        GSYNC();
        PH(3, {
            pg8::Gemm g{(const bf16_t*)(ws + WS_MIX), (const bf16_t*)(ws + WS_W2) + (size_t)l * D * D, M, D, D}; pg8::StaticOrder S; S.init(M, D, (int)gridDim.x, bid);
            EpiResid E{(GAS bf16_t*)(ws + WS_XB), (GAS float*)(ws + WS_SSQ)};
            pg8::gemm_phase<EpiResid, pg8::StaticOrder, true, true>(lds, g, S, E); });
        GSYNC();
        PH(4, {
            pg8::Gemm g{(const bf16_t*)(ws + WS_XB), (const bf16_t*)(ws + WS_W3) + (size_t)l * 2 * DFF * D, M, 2 * DFF, D}; pg8::StaticOrder S; S.init(M, 2 * DFF, (int)gridDim.x, bid);
            LAS float* rtab = (LAS float*)(lds + RTAB_OFF);
            build_rtab(rtab, S, (const GAS float*)(ws + WS_SSQ), tid);
            EpiSwiGLU E{(GAS bf16_t*)(ws + WS_PROJ), rtab};
            pg8::gemm_phase<EpiSwiGLU, pg8::StaticOrder, true, true>(lds, g, S, E);
            if (l + 1 < NL && bid >= CONV_FIRST_WG)
                convert_layer_items(PTAB(1), PTAB(2), PTAB(9), PTAB(10), PTAB(11), PTAB(12), ws, l + 1, (bid - CONV_FIRST_WG) * 8 + (tid >> 6), ((int)gridDim.x - CONV_FIRST_WG) * 8, lds + (tid >> 6) * 16384, tid & 63); });
        GSYNC();
        PH(5, {
            pg8::Gemm g{(const bf16_t*)(ws + WS_PROJ), (const bf16_t*)(ws + WS_W4) + (size_t)l * D * DFF, M, D, DFF}; pg8::StaticOrder S; S.init(M, D, (int)gridDim.x, bid);
            EpiResid E{(GAS bf16_t*)(ws + WS_XB), (GAS float*)(ws + WS_SSQ)};
            pg8::gemm_phase<EpiResid, pg8::StaticOrder, true, true>(lds, g, S, E); });
        GSYNC();
    }
    PH(8, { final_norm((GAS float*)a.out, (const GAS bf16_t*)(ws + WS_XB), (const GAS float*)(ws + WS_SSQ), PTAB(13), tid); });
}

extern "C" void kernel_launch(void* const* d_in, const int* in_sizes, int n_in, void* d_out, int out_size, void* d_ws, size_t ws_size, hipStream_t stream) {
    static int grid = 0;
    if (grid == 0) {
        if (n_in != 14 || out_size != M * D || ws_size < WS_END) { fprintf(stderr, "kernel_launch: unexpected shapes (n_in %d, out %d, ws %zu)\n", n_in, out_size, ws_size); grid = -1; return; }
        int dev = 0, cus = 0, per_cu = 0;
        (void)hipGetDevice(&dev); (void)hipDeviceGetAttribute(&cus, hipDeviceAttributeMultiprocessorCount, dev);
        if (hipFuncSetAttribute((const void*)fwd_mega, hipFuncAttributeMaxDynamicSharedMemorySize, LDS_BYTES) != hipSuccess) { fprintf(stderr, "kernel_launch: hipFuncSetAttribute failed\n"); grid = -1; return; }
        (void)hipOccupancyMaxActiveBlocksPerMultiprocessor(&per_cu, (const void*)fwd_mega, 512, LDS_BYTES);
        (void)hipGetLastError();
        if (per_cu < 1) fprintf(stderr, "kernel_launch: occupancy query says %d blocks/CU\n", per_cu);
        grid = cus;
        if (grid != 256) fprintf(stderr, "kernel_launch: %d CUs (built for 256)\n", grid);
    }
    if (grid < 0) return;
    Args a{};
    for (int i = 0; i < 14; ++i) a.in[i] = (const float*)d_in[i];
    a.out = (float*)d_out; a.ws = (unsigned char*)d_ws;
    if (hipMemsetAsync((unsigned char*)d_ws + WS_BAR, 0, 32768, stream) != hipSuccess) { fprintf(stderr, "kernel_launch: memset of barrier words failed\n"); return; }
    void* args[] = {&a};
    hipError_t e = hipLaunchCooperativeKernel((const void*)fwd_mega, dim3(grid), dim3(512), args, LDS_BYTES, stream);
    if (e != hipSuccess) fprintf(stderr, "kernel_launch: cooperative launch failed: %s (grid %d)\n", hipGetErrorString(e), grid);
}
```
